# Optimizing an MI355X kernel written in HIP

```python
import math
import jax
import jax.numpy as jnp
from jax import lax
import numpy as np

D_MODEL = 2048
BATCH = 1
SEQ = 16384
DEPTH = 2

CTX_LEN = 256
GRID_W = 64
N_MOD = 6
EPS = 1e-6
CHUNK = 64
CONV_W = 4

DN_HEADS = D_MODEL // 256
DN_DK = 128
DN_DV = 128
DN_QK = DN_HEADS * DN_DK
DN_V = DN_HEADS * DN_DV
LRU_WIDTH = D_MODEL // 2
LRU_BLOCKS = 8
LRU_BW = LRU_WIDTH // LRU_BLOCKS
LRU_C = 8.0
EV_IN = 2 * DN_QK + 2 * DN_V + 4 * DN_HEADS + 2 * LRU_WIDTH
EV_MIX = DN_V + LRU_WIDTH
GLA_HEADS = 4
GLA_QK = D_MODEL // 2
GLA_V = D_MODEL
GLA_DK = GLA_QK // GLA_HEADS
GLA_DV = GLA_V // GLA_HEADS
GLA_RANK = 16
GLA_TAU = 16.0
OD_IN = 2 * GLA_QK + 2 * GLA_V + 2 * GLA_RANK
FFN_HIDDEN = 11 * D_MODEL // 4
N_EXPERTS = 8
TOP_K = 2
MOE_BLOCK = 128

N_EVEN = (DEPTH + 1) // 2
N_ODD = DEPTH // 2

kernel_name = 'hybrid_deltanet_rglru_gla_moe_dit'


def rms_norm(x, g):
    x32 = x.astype(jnp.float32)
    y = x32 * lax.rsqrt(jnp.mean(x32 * x32, axis=-1, keepdims=True) + EPS)
    return y.astype(x.dtype) * g


def l2_normalize(t):
    t32 = t.astype(jnp.float32)
    return (t32 * lax.rsqrt(jnp.sum(t32 * t32, axis=-1, keepdims=True) + EPS)).astype(t.dtype)


def adaln(cond, w, b):
    m = jax.nn.silu(cond) @ w + b
    m = m.reshape(m.shape[0], 1, N_MOD, -1)
    return tuple(m[:, :, j] for j in range(N_MOD))


def modulate(h, shift, scale):
    return h * (1.0 + scale) + shift


def split_cols(p, sizes):
    out, start = [], 0
    for s in sizes:
        out.append(p[..., start:start + s])
        start += s
    return out


def centred_conv(x, w):
    k_w, length = w.shape[0], x.shape[1]
    left = k_w // 2
    xp = jnp.pad(x, ((0, 0), (left, k_w - 1 - left), (0, 0)))
    out = xp[:, 0:length] * w[0]
    for j in range(1, k_w):
        out = out + xp[:, j:j + length] * w[j]
    return out


def raster_transpose(t, rows, cols):
    b, n, d = t.shape
    return t.reshape(b, rows, cols, d).swapaxes(1, 2).reshape(b, n, d)


def gated_delta_chunked(q, k, v, g, beta, s0):
    b_, h_, length, _ = q.shape
    dv = v.shape[-1]
    out_dtype = v.dtype
    n = length // CHUNK
    f32 = jnp.float32
    chunks = lambda t: t.astype(f32).reshape(b_, h_, n, CHUNK, *t.shape[3:])
    q, k, v, beta = chunks(q), chunks(k), chunks(v), chunks(beta)
    gc = jnp.cumsum(chunks(g), axis=-1)
    lower = jnp.tril(jnp.ones((CHUNK, CHUNK), bool))
    strict = jnp.tril(jnp.ones((CHUNK, CHUNK), bool), -1)
    decay = jnp.exp(jnp.where(lower, gc[..., :, None] - gc[..., None, :], -jnp.inf))
    kb = k * beta[..., None]
    a = jnp.where(strict, jnp.einsum('bhnid,bhnjd->bhnij', kb, k) * decay, 0.0)
    eye = jnp.eye(CHUNK, dtype=f32)
    t_inv = lax.linalg.triangular_solve(eye + a, jnp.broadcast_to(eye, a.shape), left_side=True, lower=True, unit_diagonal=True)
    u = t_inv @ (v * beta[..., None])
    w = t_inv @ (kb * jnp.exp(gc)[..., None])
    qk = jnp.einsum('bhnid,bhnjd->bhnij', q, k) * decay
    q_dec = q * jnp.exp(gc)[..., None]
    k_dec = k * jnp.exp(gc[..., -1:] - gc)[..., None]
    g_last = jnp.exp(gc[..., -1])

    def step(s, xs):
        u_c, w_c, q_c, qk_c, k_c, gl_c = xs
        v_new = u_c - w_c @ s
        o = q_c @ s + qk_c @ v_new
        s = s * gl_c[..., None, None] + jnp.swapaxes(k_c, -1, -2) @ v_new
        return s, o

    xs = tuple(jnp.moveaxis(t, 2, 0) for t in (u, w, q_dec, qk, k_dec, g_last))
    s, o = lax.scan(step, s0.astype(f32), xs)
    return jnp.moveaxis(o, 0, 2).reshape(b_, h_, length, dv).astype(out_dtype), s.astype(s0.dtype)


def gla_chunked(q, k, v, g, s0):
    b_, h_, length, _ = q.shape
    dv = v.shape[-1]
    out_dtype = v.dtype
    n = length // CHUNK
    f32 = jnp.float32
    chunks = lambda t: jnp.moveaxis(t.astype(f32).reshape(b_, h_, n, CHUNK, t.shape[-1]), 2, 0)
    gc = jnp.cumsum(chunks(g), axis=3)
    causal = jnp.tril(jnp.ones((CHUNK, CHUNK), bool))[:, :, None]

    def step(s, xs):
        q_c, k_c, v_c, g_c = xs
        rel = jnp.exp(jnp.where(causal, g_c[:, :, :, None] - g_c[:, :, None], -jnp.inf))
        att = jnp.einsum('bhid,bhjd,bhijd->bhij', q_c, k_c, rel)
        o = (q_c * jnp.exp(g_c)) @ s + att @ v_c
        s = s * jnp.exp(g_c[:, :, -1])[..., None] + jnp.swapaxes(k_c * jnp.exp(g_c[:, :, -1:] - g_c), -1, -2) @ v_c
        return s, o

    s, o = lax.scan(step, s0.astype(f32), (chunks(q), chunks(k), chunks(v), gc))
    return jnp.moveaxis(o, 0, 2).reshape(b_, h_, length, dv).astype(out_dtype), s.astype(s0.dtype)


def linear_recurrence(a, b, h0):
    b = b.at[:, 0].add(a[:, 0] * h0)

    def combine(l, r):
        return l[0] * r[0], r[0] * l[1] + r[1]

    _, h = lax.associative_scan(combine, (a, b), axis=1)
    return h, h[:, -1]


def prefix_scan(core, ctx_args, lat_args, s0, axis, reverse):
    if reverse:
        ctx_args = tuple(jnp.flip(t, axis) for t in ctx_args)
        lat_args = tuple(jnp.flip(t, axis) for t in lat_args)
    o_ctx, s_ctx = core(*ctx_args, s0)
    o_lat, _ = core(*lat_args, s_ctx)
    if reverse:
        o_ctx, o_lat = jnp.flip(o_ctx, axis), jnp.flip(o_lat, axis)
    return o_ctx, o_lat


def bidirectional(core, ctx_shared, ctx_dir, lat_shared, lat_dir, s0, axis):
    outs = []
    for d, rev in ((0, False), (1, True)):
        ca = tuple(ctx_shared) + tuple(t[d] for t in ctx_dir)
        la = tuple(lat_shared) + tuple(t[d] for t in lat_dir)
        outs.append(prefix_scan(core, ca, la, s0, axis, rev))
    (oc_f, ol_f), (oc_b, ol_b) = outs
    return oc_f + oc_b, ol_f + ol_b


def even_mixer(h_ctx, h_lat, w_in, conv_qkv, dn_a_log, dn_dt_bias, dn_norm_g, lru_conv_w, lru_conv_b,
               lru_wa, lru_ba, lru_wx, lru_bx, lru_lambda, w_out, ctx_out):
    f32 = jnp.float32

    def prepare(h):
        bn, ln, _ = h.shape
        qkv, z, a_raw, b_raw, xr, gr = split_cols(
            h @ w_in, (2 * DN_QK + DN_V, DN_V, 2 * DN_HEADS, 2 * DN_HEADS, LRU_WIDTH, LRU_WIDTH))
        q, k, v = split_cols(jax.nn.silu(centred_conv(qkv, conv_qkv)), (DN_QK, DN_QK, DN_V))
        heads = lambda t: t.reshape(bn, ln, DN_HEADS, -1).transpose(0, 2, 1, 3)
        q = l2_normalize(heads(q)) * DN_DK ** -0.5
        k = l2_normalize(heads(k))
        v = heads(v)
        a_raw = a_raw.reshape(bn, ln, 2, DN_HEADS).transpose(2, 0, 3, 1)
        b_raw = b_raw.reshape(bn, ln, 2, DN_HEADS).transpose(2, 0, 3, 1)
        g = -jnp.exp(dn_a_log)[:, None, :, None] * jax.nn.softplus(a_raw + dn_dt_bias[:, None, :, None])
        beta = jax.nn.sigmoid(b_raw)
        xc = centred_conv(xr, lru_conv_w) + lru_conv_b
        xb = xc.reshape(bn, ln, LRU_BLOCKS, LRU_BW)
        r = jax.nn.sigmoid(jnp.einsum('blnc,dncm->dblnm', xb, lru_wa).reshape(2, bn, ln, LRU_WIDTH) + lru_ba[:, None, None])
        gi = jax.nn.sigmoid(jnp.einsum('blnc,dncm->dblnm', xb, lru_wx).reshape(2, bn, ln, LRU_WIDTH) + lru_bx[:, None, None])
        log_a = -LRU_C * r.astype(f32) * jax.nn.softplus(-lru_lambda.astype(f32))[:, None, None]
        a = jnp.exp(log_a)
        b_in = jnp.sqrt(-jnp.expm1(2.0 * log_a)) * (gi * xc).astype(f32)
        return (q, k, v), (g, beta), (a, b_in), (z, gr)

    qkv_c, gb_c, ab_c, zg_c = prepare(h_ctx)
    qkv_l, gb_l, ab_l, zg_l = prepare(h_lat)
    bn = h_lat.shape[0]
    dn_ctx, dn_lat = bidirectional(gated_delta_chunked, qkv_c, gb_c, qkv_l, gb_l,
                                   jnp.zeros((bn, DN_HEADS, DN_DK, DN_DV), h_lat.dtype), 2)
    lru_ctx, lru_lat = bidirectional(linear_recurrence, (), ab_c, (), ab_l, jnp.zeros((bn, LRU_WIDTH), f32), 1)

    def finish(o_dn, h_lru, zg):
        z, gr = zg
        bn_, ln_ = z.shape[:2]
        o = rms_norm(o_dn.transpose(0, 2, 1, 3), dn_norm_g) * jax.nn.silu(z.reshape(bn_, ln_, DN_HEADS, DN_DV))
        y_lru = h_lru.astype(z.dtype) * jax.nn.gelu(gr)
        return jnp.concatenate([o.reshape(bn_, ln_, DN_V), y_lru], axis=-1) @ w_out

    y_lat = finish(dn_lat, lru_lat, zg_l)
    y_ctx = finish(dn_ctx, lru_ctx, zg_c) if ctx_out else None
    return y_ctx, y_lat


def odd_mixer(h_ctx, h_lat, w_in, gla_wg2, gla_bg, gla_norm_g, w_out, ctx_out):
    rows = h_lat.shape[1] // GRID_W
    h_lat = raster_transpose(h_lat, rows, GRID_W)

    def prepare(h):
        bn, ln, _ = h.shape
        q, k, v, gout, gdown = split_cols(h @ w_in, (GLA_QK, GLA_QK, GLA_V, GLA_V, 2 * GLA_RANK))
        heads = lambda t: t.reshape(bn, ln, GLA_HEADS, -1).transpose(0, 2, 1, 3)
        logit = jnp.einsum('bldr,drk->dblk', gdown.reshape(bn, ln, 2, GLA_RANK), gla_wg2) + gla_bg[:, None, None]
        glog = jax.nn.log_sigmoid(logit.astype(jnp.float32)) / GLA_TAU
        glog = glog.reshape(2, bn, ln, GLA_HEADS, GLA_DK).transpose(0, 1, 3, 2, 4)
        return (heads(q) * GLA_DK ** -0.5, heads(k), heads(v)), (glog,), gout

    qkv_c, g_c, gout_c = prepare(h_ctx)
    qkv_l, g_l, gout_l = prepare(h_lat)
    bn = h_lat.shape[0]
    o_ctx, o_lat = bidirectional(gla_chunked, qkv_c, g_c, qkv_l, g_l,
                                 jnp.zeros((bn, GLA_HEADS, GLA_DK, GLA_DV), h_lat.dtype), 2)

    def finish(o, gout):
        bn_, ln_ = gout.shape[:2]
        o = rms_norm(o.transpose(0, 2, 1, 3), gla_norm_g) * jax.nn.silu(gout.reshape(bn_, ln_, GLA_HEADS, GLA_DV))
        return o.reshape(bn_, ln_, GLA_V) @ w_out

    y_lat = raster_transpose(finish(o_lat, gout_l), GRID_W, rows)
    y_ctx = finish(o_ctx, gout_c) if ctx_out else None
    return y_ctx, y_lat


def swiglu(h, w_gate, w_up, w_down):
    return (jax.nn.silu(h @ w_gate) * (h @ w_up)) @ w_down


def moe_swiglu(x, router_w, router_b, w_gate, w_up, w_down):
    n_tok, d = x.shape
    logits = (x @ router_w + router_b).astype(jnp.float32)
    top_logit, top_idx = lax.top_k(logits, TOP_K)
    top_w = jax.nn.softmax(top_logit, axis=-1).astype(x.dtype)
    n_assign = n_tok * TOP_K
    e_flat = top_idx.reshape(-1)
    tok_flat = jnp.arange(n_assign, dtype=jnp.int32) // TOP_K
    w_flat = top_w.reshape(-1)
    order = jnp.argsort(e_flat)
    e_sorted = e_flat[order]
    counts = jnp.bincount(e_flat, length=N_EXPERTS)
    padded = (counts + MOE_BLOCK - 1) // MOE_BLOCK * MOE_BLOCK
    pad_end = jnp.cumsum(padded)
    pad_start = pad_end - padded
    raw_start = jnp.cumsum(counts) - counts
    dest = pad_start[e_sorted] + jnp.arange(n_assign, dtype=jnp.int32) - raw_start[e_sorted]
    n_blocks = -(-n_assign // MOE_BLOCK) + N_EXPERTS
    n_slots = n_blocks * MOE_BLOCK
    slot_tok = jnp.full((n_slots,), n_tok, jnp.int32).at[dest].set(tok_flat[order])
    slot_w = jnp.zeros((n_slots,), x.dtype).at[dest].set(w_flat[order])
    block_expert = jnp.minimum(
        jnp.searchsorted(pad_end, jnp.arange(n_blocks, dtype=jnp.int32) * MOE_BLOCK, side='right'), N_EXPERTS - 1)
    x_pad = jnp.concatenate([x, jnp.zeros((1, d), x.dtype)], axis=0)
    xb = x_pad[slot_tok].reshape(n_blocks, MOE_BLOCK, d)

    def expert_block(args):
        xb_i, e = args
        return swiglu(xb_i, w_gate[e], w_up[e], w_down[e])

    yb = lax.map(expert_block, (xb, block_expert)).reshape(n_slots, d)
    y = jnp.zeros((n_tok + 1, d), x.dtype).at[slot_tok].add(yb * slot_w[:, None])
    return y[:n_tok]


def setup_inputs(seed: int = 0) -> dict:
    key = jax.random.key(seed)
    ks = iter(jax.random.split(key, 48))
    D = D_MODEL
    f32 = jnp.float32
    nrm = lambda shape, scale: jax.random.normal(next(ks), shape, f32) * scale
    gain = lambda shape: 1.0 + nrm(shape, 0.02)
    u_lam = jax.random.uniform(next(ks), (N_EVEN, 2, LRU_WIDTH), f32, 0.9, 0.999)
    a_lam = u_lam ** (1.0 / LRU_C)
    lam = jnp.log(a_lam) - jnp.log1p(-a_lam)
    dt = jnp.exp(jax.random.uniform(next(ks), (N_EVEN, 2, DN_HEADS), f32, math.log(1e-3), math.log(1e-1)))
    dt_bias = dt + jnp.log(-jnp.expm1(-dt))
    a_log = jnp.log(jax.random.uniform(next(ks), (N_EVEN, 2, DN_HEADS), f32, 1.0, 16.0))
    return {
        'x': nrm((BATCH, SEQ, D), 1.0),
        'c': nrm((BATCH, D), 1.0),
        'ctx': nrm((BATCH, CTX_LEN, D), 1.0),
        'c_ctx': nrm((D,), 1.0),
        'mod_w': nrm((DEPTH, D, N_MOD * D), 0.5 * D ** -0.5),
        'mod_b': nrm((DEPTH, N_MOD * D), 0.01),
        'norm1_g': gain((DEPTH, D)),
        'norm2_g': gain((DEPTH, D)),
        'ev_w_in': nrm((N_EVEN, D, EV_IN), D ** -0.5),
        'ev_conv_qkv': nrm((N_EVEN, CONV_W, 2 * DN_QK + DN_V), CONV_W ** -0.5),
        'ev_dn_a_log': a_log,
        'ev_dn_dt_bias': dt_bias,
        'ev_dn_norm_g': gain((N_EVEN, DN_DV)),
        'ev_lru_conv_w': nrm((N_EVEN, CONV_W, LRU_WIDTH), CONV_W ** -0.5),
        'ev_lru_conv_b': nrm((N_EVEN, LRU_WIDTH), 0.01),
        'ev_lru_wa': nrm((N_EVEN, 2, LRU_BLOCKS, LRU_BW, LRU_BW), LRU_BW ** -0.5),
        'ev_lru_ba': nrm((N_EVEN, 2, LRU_WIDTH), 0.01),
        'ev_lru_wx': nrm((N_EVEN, 2, LRU_BLOCKS, LRU_BW, LRU_BW), LRU_BW ** -0.5),
        'ev_lru_bx': nrm((N_EVEN, 2, LRU_WIDTH), 0.01),
        'ev_lru_lambda': lam,
        'ev_w_out': nrm((N_EVEN, EV_MIX, D), EV_MIX ** -0.5),
        'ev_ffn_w_gate': nrm((N_EVEN, D, FFN_HIDDEN), D ** -0.5),
        'ev_ffn_w_up': nrm((N_EVEN, D, FFN_HIDDEN), D ** -0.5),
        'ev_ffn_w_down': nrm((N_EVEN, FFN_HIDDEN, D), FFN_HIDDEN ** -0.5),
        'od_w_in': nrm((N_ODD, D, OD_IN), D ** -0.5),
        'od_gla_wg2': nrm((N_ODD, 2, GLA_RANK, GLA_QK), GLA_RANK ** -0.5),
        'od_gla_bg': nrm((N_ODD, 2, GLA_QK), 0.01),
        'od_gla_norm_g': gain((N_ODD, GLA_DV)),
        'od_w_out': nrm((N_ODD, GLA_V, D), GLA_V ** -0.5),
        'od_router_w': nrm((N_ODD, D, N_EXPERTS), D ** -0.5),
        'od_router_b': nrm((N_ODD, N_EXPERTS), 0.01),
        'od_exp_w_gate': nrm((N_ODD, N_EXPERTS, D, FFN_HIDDEN), D ** -0.5),
        'od_exp_w_up': nrm((N_ODD, N_EXPERTS, D, FFN_HIDDEN), D ** -0.5),
        'od_exp_w_down': nrm((N_ODD, N_EXPERTS, FFN_HIDDEN, D), FFN_HIDDEN ** -0.5),
        'final_norm_g': gain((D,)),
    }


def reference(x, c, ctx, c_ctx, mod_w, mod_b, norm1_g, norm2_g, ev_w_in, ev_conv_qkv, ev_dn_a_log, ev_dn_dt_bias,
              ev_dn_norm_g, ev_lru_conv_w, ev_lru_conv_b, ev_lru_wa, ev_lru_ba, ev_lru_wx, ev_lru_bx, ev_lru_lambda,
              ev_w_out, ev_ffn_w_gate, ev_ffn_w_up, ev_ffn_w_down, od_w_in, od_gla_wg2, od_gla_bg, od_gla_norm_g,
              od_w_out, od_router_w, od_router_b, od_exp_w_gate, od_exp_w_up, od_exp_w_down, final_norm_g):
    b_, length, d = x.shape
    for layer in range(DEPTH):
        i = layer // 2
        last = layer == DEPTH - 1
        sh1, sc1, gt1, sh2, sc2, gt2 = adaln(c, mod_w[layer], mod_b[layer])
        csh1, csc1, cgt1, csh2, csc2, cgt2 = adaln(c_ctx[None], mod_w[layer], mod_b[layer])
        h_lat = modulate(rms_norm(x, norm1_g[layer]), sh1, sc1)
        h_ctx = modulate(rms_norm(ctx, norm1_g[layer]), csh1, csc1)
        if layer % 2 == 0:
            y_ctx, y_lat = even_mixer(h_ctx, h_lat, ev_w_in[i], ev_conv_qkv[i], ev_dn_a_log[i], ev_dn_dt_bias[i],
                                      ev_dn_norm_g[i], ev_lru_conv_w[i], ev_lru_conv_b[i], ev_lru_wa[i], ev_lru_ba[i],
                                      ev_lru_wx[i], ev_lru_bx[i], ev_lru_lambda[i], ev_w_out[i], not last)
            ffn = lambda t: swiglu(t, ev_ffn_w_gate[i], ev_ffn_w_up[i], ev_ffn_w_down[i])
        else:
            y_ctx, y_lat = odd_mixer(h_ctx, h_lat, od_w_in[i], od_gla_wg2[i], od_gla_bg[i], od_gla_norm_g[i],
                                     od_w_out[i], not last)
            ffn = lambda t: moe_swiglu(t.reshape(-1, d), od_router_w[i], od_router_b[i], od_exp_w_gate[i],
                                       od_exp_w_up[i], od_exp_w_down[i]).reshape(t.shape)
        x = x + gt1 * y_lat
        x = x + gt2 * ffn(modulate(rms_norm(x, norm2_g[layer]), sh2, sc2))
        if not last:
            ctx = ctx + cgt1 * y_ctx
            ctx = ctx + cgt2 * ffn(modulate(rms_norm(ctx, norm2_g[layer]), csh2, csc2))
    return rms_norm(x, final_norm_g)
```

```cpp
#include <hip/hip_runtime.h>
#include <cstdio>
#include <cstdint>

#ifndef MK_ONE_LAUNCH
#define MK_ONE_LAUNCH 0
#endif

#define GAS __attribute__((address_space(1)))
#define LAS __attribute__((address_space(3)))
typedef unsigned short bf16;
typedef float f32x4 __attribute__((ext_vector_type(4)));
typedef float f32x2 __attribute__((ext_vector_type(2)));
typedef unsigned u32x4 __attribute__((ext_vector_type(4)));
typedef unsigned u32x2 __attribute__((ext_vector_type(2)));
typedef short bf16x8 __attribute__((ext_vector_type(8)));

constexpr int D = 2048, T = 16384, CT = 256, MT = T + CT, FF = 5632;
constexpr int NPROJ = 6144, NPROJ_PAD = 6400, EV_IN = 6176;
constexpr int NEXP = 8;
constexpr float EPS = 1e-6f;
constexpr int XS_ROWS = 34816;

constexpr size_t MiB = 1u << 20;
constexpr size_t WS_CTL = 0, CTL_BYTES = 1 * MiB;
constexpr size_t WS_MOD = 1 * MiB;
constexpr size_t WS_SMALL = 2 * MiB;
constexpr size_t WS_W_EVIN = 4 * MiB;
constexpr size_t WS_W_EVOUT = WS_W_EVIN + 25 * MiB;
constexpr size_t WS_W_EVGU = WS_W_EVOUT + 8 * MiB;
constexpr size_t WS_W_EVDN = WS_W_EVGU + 44 * MiB;
constexpr size_t WS_W_ODIN = WS_W_EVDN + 22 * MiB;
constexpr size_t WS_W_ODOUT = WS_W_ODIN + 25 * MiB;
constexpr size_t WS_W_XGU = WS_W_ODOUT + 8 * MiB;
constexpr size_t WS_W_XDN = WS_W_XGU + 352 * MiB;
constexpr size_t WS_XRES = WS_W_XDN + 176 * MiB;
constexpr size_t WS_H = WS_XRES + 130 * MiB;
constexpr size_t WS_S = WS_H + 65 * MiB;
constexpr size_t WS_PROJ = WS_S;
constexpr size_t WS_AUX = WS_S + 195 * MiB;
constexpr size_t WS_QN = WS_AUX + 3 * MiB;
constexpr size_t WS_KN = WS_QN + 33 * MiB;
constexpr size_t WS_VC = WS_KN + 33 * MiB;
constexpr size_t WS_XC = WS_VC + 33 * MiB;
constexpr size_t WS_GB = WS_XC + 33 * MiB;
constexpr size_t WS_LOGA = WS_GB + 5 * MiB;
constexpr size_t WS_BIN = WS_LOGA + 65 * MiB;
constexpr size_t WS_ODN = WS_BIN + 65 * MiB;
constexpr size_t WS_HLRU = WS_ODN + 65 * MiB;
constexpr size_t WS_MIX = WS_HLRU + 65 * MiB;
constexpr size_t WS_L0_END = WS_MIX + 65 * MiB;
constexpr size_t WS_HID = WS_S;
constexpr size_t WS_OGLA = WS_QN;
constexpr size_t WS_HID2 = WS_S;
constexpr size_t WS_XS = WS_S + 374 * MiB;
constexpr size_t WS_YB = WS_XS + 136 * MiB;
constexpr size_t WS_END = WS_YB + 136 * MiB;
static_assert(WS_L0_END <= 1640 * MiB && WS_END <= 1640 * MiB, "workspace map");
static_assert(WS_OGLA + 128 * MiB <= WS_MIX, "OGLA vs MIX");
constexpr size_t SM_TOPI = 0;
constexpr size_t SM_TOPW = 128 * 1024;
constexpr size_t SM_POS = 256 * 1024;
constexpr size_t SM_SLOT = 384 * 1024;
constexpr size_t SM_WGBASE = 512 * 1024;
constexpr int CW_CNT = 64;
constexpr int CW_BAR = 4096;

__device__ __forceinline__ float bf2f(unsigned b) { return __uint_as_float(b << 16); }
__device__ __forceinline__ unsigned cvt_pk_bf16(float lo, float hi) { unsigned r; asm volatile("v_cvt_pk_bf16_f32 %0, %1, %2" : "=v"(r) : "v"(lo), "v"(hi)); return r; }
__device__ __forceinline__ unsigned short f2bf(float f) { return (unsigned short)(cvt_pk_bf16(f, 0.f) & 0xffffu); }
__device__ __forceinline__ void unpack8(const u32x4 w, float (&o)[8]) {
    o[0] = __uint_as_float(w.x << 16); o[1] = __uint_as_float(w.x & 0xffff0000u); o[2] = __uint_as_float(w.y << 16); o[3] = __uint_as_float(w.y & 0xffff0000u);
    o[4] = __uint_as_float(w.z << 16); o[5] = __uint_as_float(w.z & 0xffff0000u); o[6] = __uint_as_float(w.w << 16); o[7] = __uint_as_float(w.w & 0xffff0000u);
}
__device__ __forceinline__ u32x4 pack8(const float (&v)[8]) { u32x4 w; w.x = cvt_pk_bf16(v[0], v[1]); w.y = cvt_pk_bf16(v[2], v[3]); w.z = cvt_pk_bf16(v[4], v[5]); w.w = cvt_pk_bf16(v[6], v[7]); return w; }
__device__ __forceinline__ float sigmoidf_(float x) { return 1.0f / (1.0f + expf(-x)); }
__device__ __forceinline__ float siluf_(float x) { return x / (1.0f + expf(-x)); }
__device__ __forceinline__ float softplusf_(float x) { return fmaxf(x, 0.f) + log1pf(expf(-fabsf(x))); }
__device__ __forceinline__ float gelu_tanh(float x) { const float u = 0.7978845608028654f * (x + 0.044715f * x * x * x); return 0.5f * x * (1.0f + tanhf(u)); }
__device__ __forceinline__ float wave_sum(float v) {
#pragma unroll
    for (int o = 1; o < 64; o <<= 1) v += __shfl_xor(v, o);
    return v;
}
__device__ __forceinline__ float sum16(float v) {
#pragma unroll
    for (int o = 1; o < 16; o <<= 1) v += __shfl_xor(v, o);
    return v;
}

namespace pg8 {
#define PG8_LAS __attribute__((address_space(3)))
typedef unsigned short bf16_t;
constexpr int BM = 256, BK = 64, HALF = 128, HTB = HALF * BK * 2, STAGE_BYTES = 8 * HTB, NXCD = 8, WGM = 8;
__host__ __device__ __forceinline__ int lds_byte(int r, int c) { const int st = (r >> 4) * 2 + (c >> 5), rr = r & 15, cc = c & 31, ob = rr * 64 + cc * 2; return st * 1024 + (ob ^ (((ob >> 9) & 1) << 5)); }
__host__ __device__ __forceinline__ void stage_rc(int b, int& R, int& C) { const int st = b / 1024, sb = b % 1024, swz = sb ^ (((sb >> 9) & 1) << 5); R = (st >> 1) * 16 + swz / 64; C = (st & 1) * 32 + (swz % 64) / 2; }
__host__ __device__ __forceinline__ int perm32(int rho) { const int n = rho >> 4, i = rho & 15; return 8 * (i >> 2) + 4 * n + (i & 3); }

struct Unit { int pm, pn; };
struct Gemm { const bf16_t* A; const bf16_t* Bt; int M, N, K; };

struct StaticOrder {
    int nM, nN, nwg, G, c;
    __host__ __device__ void init(int M, int N, int G_, int c_) { nM = M / BM; nN = N / BM; nwg = nM * nN; G = G_; c = c_; }
    __host__ __device__ bool next(int i, Unit& u) const {
        const long L = (long)i * G + c; if (L >= nwg) return false;
        int wgid = (int)L; { const int q = nwg / NXCD, r = nwg % NXCD, xcd = wgid % NXCD, off = wgid / NXCD; wgid = (xcd < r ? xcd * (q + 1) : r * (q + 1) + (xcd - r) * q) + off; }
        const int nig = WGM * nN, gid = wgid / nig, fm = gid * WGM, gsz = (nM - fm) < WGM ? (nM - fm) : WGM;
        u.pm = fm + ((wgid % nig) % gsz); u.pn = (wgid % nig) / gsz; return true;
    }
    __device__ __forceinline__ void a_ready(const Unit&) const {}
    __device__ __forceinline__ void done(const Unit&) const {}
};
struct MoeOrder {
    int nN, Mt, nwg, G, c; int tend[8];
    __device__ bool next(int i, Unit& u) const {
        const long L = (long)i * G + c; if (L >= nwg) return false;
        int wgid = (int)L; { const int q = nwg / NXCD, r = nwg % NXCD, xcd = wgid % NXCD, off = wgid / NXCD; wgid = (xcd < r ? xcd * (q + 1) : r * (q + 1) + (xcd - r) * q) + off; }
        const int nig = WGM * nN, gid = wgid / nig, fm = gid * WGM, gsz = (Mt - fm) < WGM ? (Mt - fm) : WGM;
        const int pm = fm + ((wgid % nig) % gsz), pnl = (wgid % nig) / gsz;
        int e = 0;
#pragma unroll
        for (int j = 0; j < 7; ++j) e += (pm >= tend[j]) ? 1 : 0;
        u.pm = pm; u.pn = e * nN + pnl; return true;
    }
    __device__ __forceinline__ void a_ready(const Unit&) const {}
    __device__ __forceinline__ void done(const Unit&) const {}
};

struct EpiProj {
    static constexpr bool PERM = true, AFTER_DRAIN = false;
    bf16_t* O; float* AUX; int ldc, npn;
    __device__ __forceinline__ void operator()(const f32x4 (&acc)[2][2][4][2], const Unit& u, int wr, int wc, int fr, int fq) const {
        const int row0 = u.pm * BM + wr * 64 + fr;
        if (u.pn < npn) {
            const int col0 = u.pn * BM + wc * 32 + 8 * fq;
#pragma unroll
            for (int ai = 0; ai < 2; ++ai)
#pragma unroll
                for (int m = 0; m < 4; ++m) { bf16_t* rowp = O + (size_t)(row0 + ai * HALF + m * 16) * ldc + col0;
#pragma unroll
                    for (int bj = 0; bj < 2; ++bj) { const f32x4 v0 = acc[ai][bj][m][0], v1 = acc[ai][bj][m][1];
                        u32x4 w; w.x = cvt_pk_bf16(v0[0], v0[1]); w.y = cvt_pk_bf16(v0[2], v0[3]); w.z = cvt_pk_bf16(v1[0], v1[1]); w.w = cvt_pk_bf16(v1[2], v1[3]);
                        *(u32x4*)(rowp + bj * HALF) = w; } }
        } else if (wc == 0) {
#pragma unroll
            for (int ai = 0; ai < 2; ++ai)
#pragma unroll
                for (int m = 0; m < 4; ++m) { float* rowp = AUX + (size_t)(row0 + ai * HALF + m * 16) * 32 + 8 * fq;
                    *(f32x4*)(rowp) = acc[ai][0][m][0]; *(f32x4*)(rowp + 4) = acc[ai][0][m][1]; }
        }
    }
};
struct EpiResid {
    static constexpr bool PERM = false, AFTER_DRAIN = false;
    float* X; const float* gate_lat; const float* gate_ctx;
    __device__ __forceinline__ void operator()(const f32x4 (&acc)[2][2][4][2], const Unit& u, int wr, int wc, int fr, int fq) const {
        const float* gate = (u.pm >= 64) ? gate_ctx : gate_lat;
        const int row0 = u.pm * BM + wr * 64 + fr, col0 = u.pn * BM + wc * 32 + 4 * fq;
        f32x4 gv[2][2];
#pragma unroll
        for (int bj = 0; bj < 2; ++bj)
#pragma unroll
            for (int n = 0; n < 2; ++n) gv[bj][n] = *(const f32x4*)(gate + col0 + bj * HALF + n * 16);
#pragma unroll
        for (int ai = 0; ai < 2; ++ai)
#pragma unroll
            for (int m = 0; m < 4; ++m) { float* rowp = X + (size_t)(row0 + ai * HALF + m * 16) * D + col0;
#pragma unroll
                for (int bj = 0; bj < 2; ++bj)
#pragma unroll
                    for (int n = 0; n < 2; ++n) { f32x4* p = (f32x4*)(rowp + bj * HALF + n * 16); *p = *p + gv[bj][n] * acc[ai][bj][m][n]; } }
    }
};
struct EpiSwiglu {
    static constexpr bool PERM = true, AFTER_DRAIN = false;
    bf16_t* O; int ldc, nN;
    __device__ __forceinline__ void operator()(const f32x4 (&acc)[2][2][4][2], const Unit& u, int wr, int wc, int fr, int fq) const {
        const int pnl = u.pn % nN;
        const int row0 = u.pm * BM + wr * 64 + fr, col0 = pnl * HALF + wc * 32 + 8 * fq;
#pragma unroll
        for (int ai = 0; ai < 2; ++ai)
#pragma unroll
            for (int m = 0; m < 4; ++m) { bf16_t* rowp = O + (size_t)(row0 + ai * HALF + m * 16) * ldc + col0;
                float h[8];
#pragma unroll
                for (int n = 0; n < 2; ++n)
#pragma unroll
                    for (int j = 0; j < 4; ++j) { const float g = acc[ai][0][m][n][j], up = acc[ai][1][m][n][j]; h[4 * n + j] = g / (1.0f + __expf(-g)) * up; }
                u32x4 w; w.x = cvt_pk_bf16(h[0], h[1]); w.y = cvt_pk_bf16(h[2], h[3]); w.z = cvt_pk_bf16(h[4], h[5]); w.w = cvt_pk_bf16(h[6], h[7]);
                *(u32x4*)(rowp) = w; }
    }
};
struct EpiBf16N {
    static constexpr bool PERM = true, AFTER_DRAIN = false;
    bf16_t* O; int ldc, nN;
    __device__ __forceinline__ void operator()(const f32x4 (&acc)[2][2][4][2], const Unit& u, int wr, int wc, int fr, int fq) const {
        const int pnl = u.pn % nN;
        const int row0 = u.pm * BM + wr * 64 + fr, col0 = pnl * BM + wc * 32 + 8 * fq;
#pragma unroll
        for (int ai = 0; ai < 2; ++ai)
#pragma unroll
            for (int m = 0; m < 4; ++m) { bf16_t* rowp = O + (size_t)(row0 + ai * HALF + m * 16) * ldc + col0;
#pragma unroll
                for (int bj = 0; bj < 2; ++bj) { const f32x4 v0 = acc[ai][bj][m][0], v1 = acc[ai][bj][m][1];
                    u32x4 w; w.x = cvt_pk_bf16(v0[0], v0[1]); w.y = cvt_pk_bf16(v0[2], v0[3]); w.z = cvt_pk_bf16(v1[0], v1[1]); w.w = cvt_pk_bf16(v1[2], v1[3]);
                    *(u32x4*)(rowp + bj * HALF) = w; } }
    }
};

template <class Epi, class Sched, bool ALIGN_EPI = false, bool SP2 = false>
__device__ __forceinline__ void gemm_phase(PG8_LAS unsigned char* lds, const Gemm g, const Sched& S, const Epi& E) {
    const int tid = threadIdx.x, wid = __builtin_amdgcn_readfirstlane(tid >> 6), lane = tid & 63, wr = wid >> 2, wc = wid & 3, fr = lane & 15, fq = lane >> 4;
    const int K = g.K, nt = K / BK;
    unsigned voffA[2], voffB[2];
#pragma unroll
    for (int i = 0; i < 2; ++i) { int R, C; stage_rc(tid * 16 + i * 8192, R, C); const int Rb = Epi::PERM ? ((R & ~31) + perm32(R & 31)) : R;
        voffA[i] = (unsigned)(R * K + C) * 2u; voffB[i] = (unsigned)(Rb * K + C) * 2u; }
    const size_t kstep = (size_t)(BK * 2);
    const size_t hstep = (size_t)HALF * K * 2;
    const size_t tstep = 2 * hstep;
    const unsigned ldsw = (unsigned)wid * 1024u;
    const int aoff = lds_byte(wr * 64 + fr, fq * 8), boff = lds_byte(wc * 32 + fr, fq * 8);
#define PG8_SA(b, h) (((b) * 2 + (h)) * HTB)
#define PG8_SB(b, h) ((4 + (b) * 2 + (h)) * HTB)
#define PG8_STAGE(bufoff, gbase, voff) do { _Pragma("unroll") for (int _i = 0; _i < 2; ++_i) \
        __builtin_amdgcn_global_load_lds((const unsigned*)((const char*)(gbase) + (voff)[_i]), (PG8_LAS unsigned*)(lds + (bufoff) + ldsw + _i * 8192), 16, 0, 0); } while (0)
#define PG8_LDA(dst, b, h) do { _Pragma("unroll") for (int m = 0; m < 4; ++m) _Pragma("unroll") for (int k = 0; k < 2; ++k) dst[m][k] = *(const PG8_LAS bf16x8*)(lds + PG8_SA(b, h) + aoff + m * 2048 + k * 1024); } while (0)
#define PG8_LDB(dst, b, h) do { _Pragma("unroll") for (int n = 0; n < 2; ++n) _Pragma("unroll") for (int k = 0; k < 2; ++k) dst[n][k] = *(const PG8_LAS bf16x8*)(lds + PG8_SB(b, h) + boff + n * 2048 + k * 1024); } while (0)
#define PG8_MMA(ai, bj, At, Bt) do { __builtin_amdgcn_s_setprio(1); _Pragma("unroll") for (int m = 0; m < 4; ++m) _Pragma("unroll") for (int n = 0; n < 2; ++n) _Pragma("unroll") for (int k = 0; k < 2; ++k) \
        acc[ai][bj][m][n] = __builtin_amdgcn_mfma_f32_16x16x32_bf16(Bt[n][k], At[m][k], acc[ai][bj][m][n], 0, 0, 0); __builtin_amdgcn_s_setprio(0); } while (0)
#define PG8_WAIT_V(n) asm volatile("s_waitcnt vmcnt(" #n ")" ::: "memory")
#define PG8_WAIT_L(n) asm volatile("s_waitcnt lgkmcnt(" #n ")" ::: "memory")
#define PG8_BAR __builtin_amdgcn_s_barrier()
#define PG8_SCHED __builtin_amdgcn_sched_barrier(0)
    Unit cur, nxt; int ui = 0;
    if (!S.next(0, cur)) return;
    f32x4 acc[2][2][4][2];
#pragma unroll
    for (int a = 0; a < 2; ++a)
#pragma unroll
        for (int b = 0; b < 2; ++b)
#pragma unroll
            for (int m = 0; m < 4; ++m)
#pragma unroll
                for (int n = 0; n < 2; ++n) acc[a][b][m][n] = (f32x4){0.f, 0.f, 0.f, 0.f};
    bf16x8 At[4][2], B0[2][2], B1[2][2];
    const char* cA = (const char*)g.A + (size_t)cur.pm * tstep; const char* cB = (const char*)g.Bt + (size_t)cur.pn * tstep;
    S.a_ready(cur);
    if constexpr (SP2) {
        PG8_STAGE(PG8_SB(0, 0), cB, voffB); PG8_STAGE(PG8_SB(0, 1), cB + hstep, voffB); PG8_STAGE(PG8_SA(0, 0), cA, voffA); PG8_STAGE(PG8_SA(0, 1), cA + hstep, voffA);
        if (wr == 1) PG8_BAR;
        PG8_WAIT_V(2); PG8_BAR;
        PG8_STAGE(PG8_SB(1, 0), cB + kstep, voffB); PG8_STAGE(PG8_SA(1, 0), cA + kstep, voffA); PG8_STAGE(PG8_SB(1, 1), cB + hstep + kstep, voffB);
        PG8_WAIT_V(6); PG8_BAR;
    } else {
        PG8_STAGE(PG8_SB(0, 0), cB, voffB); PG8_STAGE(PG8_SA(0, 0), cA, voffA); PG8_STAGE(PG8_SB(0, 1), cB + hstep, voffB); PG8_STAGE(PG8_SA(0, 1), cA + hstep, voffA);
        if (wr == 1) PG8_BAR;
        PG8_WAIT_V(4); PG8_BAR;
        PG8_STAGE(PG8_SB(1, 0), cB + kstep, voffB); PG8_STAGE(PG8_SA(1, 0), cA + kstep, voffA); PG8_STAGE(PG8_SB(1, 1), cB + hstep + kstep, voffB);
        PG8_WAIT_V(6); PG8_BAR;
    }
    for (;;) {
        const bool has_next = S.next(ui + 1, nxt);
        const char* nA = has_next ? (const char*)g.A + (size_t)nxt.pm * tstep : cA; const char* nB = has_next ? (const char*)g.Bt + (size_t)nxt.pn * tstep : cB;
        for (int t = 0; t < nt; t += 2) {
            const bool last = (t == nt - 2);
            const char* a1 = cA + (size_t)(t + 1) * kstep;
            const char* a2 = last ? nA : cA + (size_t)(t + 2) * kstep; const char* b2 = last ? nB : cB + (size_t)(t + 2) * kstep;
            const char* a3 = a2 + kstep; const char* b3 = b2 + kstep;
            if (last && has_next) S.a_ready(nxt);
            if constexpr (SP2) {
            PG8_LDB(B0, 0, 0); PG8_LDB(B1, 0, 1); PG8_SCHED; PG8_LDA(At, 0, 0); PG8_STAGE(PG8_SA(1, 1), a1 + hstep, voffA);
            PG8_WAIT_V(8); PG8_WAIT_L(0); PG8_BAR; PG8_MMA(0, 0, At, B0); PG8_MMA(0, 1, At, B1); PG8_BAR; PG8_SCHED;
            PG8_LDA(At, 0, 1); PG8_STAGE(PG8_SB(0, 0), b2, voffB); PG8_STAGE(PG8_SB(0, 1), b2 + hstep, voffB); PG8_STAGE(PG8_SA(0, 0), a2, voffA);
            PG8_WAIT_V(8); PG8_WAIT_L(0); PG8_BAR; PG8_MMA(1, 0, At, B0); PG8_MMA(1, 1, At, B1); PG8_BAR; PG8_SCHED;
            PG8_LDB(B0, 1, 0); PG8_LDB(B1, 1, 1); PG8_SCHED; PG8_LDA(At, 1, 0); PG8_STAGE(PG8_SA(0, 1), a2 + hstep, voffA);
            PG8_WAIT_V(8); PG8_WAIT_L(0); PG8_BAR; PG8_MMA(0, 0, At, B0); PG8_MMA(0, 1, At, B1); PG8_BAR; PG8_SCHED;
            PG8_LDA(At, 1, 1); PG8_STAGE(PG8_SB(1, 0), b3, voffB); PG8_STAGE(PG8_SB(1, 1), b3 + hstep, voffB); PG8_STAGE(PG8_SA(1, 0), a3, voffA);
            PG8_WAIT_V(8); PG8_WAIT_L(0); PG8_BAR; PG8_MMA(1, 0, At, B0); PG8_MMA(1, 1, At, B1); PG8_BAR; PG8_SCHED;
            } else {
            PG8_LDB(B0, 0, 0); PG8_SCHED; PG8_LDA(At, 0, 0); PG8_STAGE(PG8_SA(1, 1), a1 + hstep, voffA);
            PG8_WAIT_L(8); PG8_BAR; PG8_WAIT_L(0); PG8_MMA(0, 0, At, B0); PG8_BAR; PG8_SCHED;
            PG8_LDB(B1, 0, 1); PG8_STAGE(PG8_SB(0, 0), b2, voffB);
            PG8_BAR; PG8_WAIT_L(0); PG8_MMA(0, 1, At, B1); PG8_BAR;
            PG8_LDA(At, 0, 1); PG8_STAGE(PG8_SA(0, 0), a2, voffA);
            PG8_BAR; PG8_WAIT_L(0); PG8_MMA(1, 0, At, B0); PG8_BAR; PG8_SCHED;
            PG8_STAGE(PG8_SB(0, 1), b2 + hstep, voffB);
            PG8_WAIT_V(6); PG8_BAR; PG8_MMA(1, 1, At, B1); PG8_BAR;
            PG8_LDB(B0, 1, 0); PG8_SCHED; PG8_LDA(At, 1, 0); PG8_STAGE(PG8_SA(0, 1), a2 + hstep, voffA);
            PG8_WAIT_L(8); PG8_BAR; PG8_WAIT_L(0); PG8_MMA(0, 0, At, B0); PG8_BAR; PG8_SCHED;
            PG8_LDB(B1, 1, 1); PG8_STAGE(PG8_SB(1, 0), b3, voffB);
            PG8_BAR; PG8_WAIT_L(0); PG8_MMA(0, 1, At, B1); PG8_BAR;
            PG8_LDA(At, 1, 1); PG8_STAGE(PG8_SA(1, 0), a3, voffA);
            PG8_BAR; PG8_WAIT_L(0); PG8_MMA(1, 0, At, B0); PG8_BAR; PG8_SCHED;
            PG8_STAGE(PG8_SB(1, 1), b3 + hstep, voffB);
            PG8_WAIT_V(6); PG8_BAR; PG8_MMA(1, 1, At, B1); PG8_BAR;
            }
        }
        if constexpr (ALIGN_EPI) { if (wr == 0) PG8_BAR; }
        if constexpr (!Epi::AFTER_DRAIN) { E(acc, cur, wr, wc, fr, fq); S.done(cur); }
        if (!has_next) break;
#pragma unroll
        for (int a = 0; a < 2; ++a)
#pragma unroll
            for (int b = 0; b < 2; ++b)
#pragma unroll
                for (int m = 0; m < 4; ++m)
#pragma unroll
                    for (int n = 0; n < 2; ++n) acc[a][b][m][n] = (f32x4){0.f, 0.f, 0.f, 0.f};
        cur = nxt; cA = nA; cB = nB; ++ui;
        if constexpr (ALIGN_EPI) { if (wr == 1) PG8_BAR; }
    }
    PG8_WAIT_V(0);
    if constexpr (!ALIGN_EPI) { if (wr == 0) PG8_BAR; }
    PG8_BAR;
#undef PG8_SA
#undef PG8_SB
#undef PG8_STAGE
#undef PG8_LDA
#undef PG8_LDB
#undef PG8_MMA
#undef PG8_WAIT_V
#undef PG8_WAIT_L
#undef PG8_BAR
#undef PG8_SCHED
}
}

#define XB_TMO      128
#define XB_XCNT(j)  (256  + 64 * (j))
#define XB_XSUB(j)  (1280 + 64 * (j))
#define XB_XGEN(j)  (2304 + 64 * (j))
#define XB_TOP      3328
#define XB_TOPGEN   3392
#define XCD_BAR_WORDS 3456
#define XB_SPIN_CAP (1u << 21)
__device__ __forceinline__ unsigned xb_ld(unsigned* p)              { return __hip_atomic_load(p, __ATOMIC_RELAXED, __HIP_MEMORY_SCOPE_AGENT); }
__device__ __forceinline__ unsigned xb_add(unsigned* p, unsigned v) { return __hip_atomic_fetch_add(p, v, __ATOMIC_RELAXED, __HIP_MEMORY_SCOPE_AGENT); }
__device__ __forceinline__ unsigned xb_xcc_id() { return (unsigned)__builtin_amdgcn_s_getreg((3 << 11) | 20) & 0xFu; }
#define XB_SPIN(cond, bar) do { unsigned _sp = 0; while (cond) { __builtin_amdgcn_s_sleep(1); \
    if ((++_sp & 255u) == 0u) { if (xb_ld(&(bar)[XB_TMO])) break; if (_sp > XB_SPIN_CAP) { atomicAdd(&(bar)[XB_TMO], 1u); break; } } } } while (0)
struct XcdBarrier { unsigned* bar; unsigned x; volatile LAS unsigned* st; };
__device__ __forceinline__ XcdBarrier xcd_barrier_post(unsigned* bar, volatile LAS unsigned* st) {
    XcdBarrier b; b.bar = bar; b.x = xb_xcc_id(); b.st = st;
    if (threadIdx.x == 0) (void)xb_add(&bar[XB_XCNT(b.x)], 1u);
    return b;
}
__device__ __forceinline__ void xcd_barrier_complete(unsigned* bar, unsigned x, unsigned& nloc, unsigned& nx) {
    const unsigned G = gridDim.x * gridDim.y * gridDim.z;
    unsigned sum, cnt, mine, sp = 0u;
    for (;;) {
        sum = 0u; cnt = 0u; mine = 0u;
#pragma unroll
        for (unsigned j = 0; j < 16; ++j) { const unsigned c = xb_ld(&bar[XB_XCNT(j)]); sum += c; cnt += (c > 0u) ? 1u : 0u; mine = (j == x) ? c : mine; }
        if (sum == G) break;
        __builtin_amdgcn_s_sleep(1);
        if ((++sp & 255u) == 0u) { if (xb_ld(&bar[XB_TMO])) break; if (sp > XB_SPIN_CAP) { atomicAdd(&bar[XB_TMO], 1u); break; } }
    }
    nloc = mine > 0u ? mine : 1u; nx = cnt > 0u ? cnt : 1u;
}
__device__ __forceinline__ void xcd_barrier(const XcdBarrier& b) {
    asm volatile("s_waitcnt vmcnt(0)" ::: "memory");
    __syncthreads();
    if (threadIdx.x == 0) {
        unsigned* bar = b.bar;
        __builtin_amdgcn_s_waitcnt(0);
        unsigned nloc = b.st[0], nx = b.st[1];
        if (nloc == 0u) { xcd_barrier_complete(bar, b.x, nloc, nx); b.st[0] = nloc; b.st[1] = nx; }
        const unsigned old = xb_add(&bar[XB_XSUB(b.x)], 1u);
        const unsigned gen = old / nloc;
        if (old + 1u == (gen + 1u) * nloc) {
            __builtin_amdgcn_fence(__ATOMIC_RELEASE, "agent");
            asm volatile("s_waitcnt vmcnt(0)" ::: "memory");
            const unsigned og = xb_add(&bar[XB_TOP], 1u);
            const unsigned tg = og / nx;
            if (og + 1u == (tg + 1u) * nx) xb_add(&bar[XB_TOPGEN], 1u);
            else XB_SPIN(xb_ld(&bar[XB_TOPGEN]) == tg, bar);
            __builtin_amdgcn_fence(__ATOMIC_ACQUIRE, "agent");
            xb_add(&bar[XB_XGEN(b.x)], 1u);
            asm volatile("s_waitcnt vmcnt(0)" ::: "memory");
        } else {
            XB_SPIN(xb_ld(&bar[XB_XGEN(b.x)]) == gen, bar);
            __builtin_amdgcn_fence(__ATOMIC_ACQUIRE, "agent");
            asm volatile("s_waitcnt vmcnt(0)" ::: "memory");
        }
    }
    __syncthreads();
}

constexpr int NWAVES = 8, NTHREADS = 512;
constexpr int RING_BYTES = 131072;
constexpr int LDSCTL_OFF = RING_BYTES;
constexpr int LDS_BYTES = 147456;
enum { IN_X = 0, IN_C, IN_CTX, IN_CCTX, IN_MODW, IN_MODB, IN_N1G, IN_N2G, IN_EVWIN, IN_EVCONV, IN_ALOG, IN_DTB, IN_DNG, IN_LCW, IN_LCB, IN_LWA, IN_LBA, IN_LWX, IN_LBX, IN_LAM,
       IN_EVWOUT, IN_EVGATE, IN_EVUP, IN_EVDOWN, IN_ODWIN, IN_WG2, IN_BG, IN_GLAG, IN_ODWOUT, IN_RW, IN_RB, IN_XGATE, IN_XUP, IN_XDOWN, IN_FNG, N_IN };
struct Args { const float* in[N_IN]; float* out; unsigned char* ws; int ph_lo, ph_hi; };
constexpr int N_PHASES = 21;

__device__ __forceinline__ void p0_adaln(const Args& a, LAS unsigned char* lds, int tid) {
    LAS float* s0 = (LAS float*)lds; LAS float* s1 = s0 + D; LAS float* red = s1 + D;
    for (int i = tid; i < D; i += NTHREADS) { s0[i] = siluf_(a.in[IN_C][i]); s1[i] = siluf_(a.in[IN_CCTX][i]); }
    __syncthreads();
    float* MOD = (float*)(a.ws + WS_MOD);
    const int cl = tid & 31, kg = tid >> 5;
    for (int item = blockIdx.x; item < 2 * 96; item += gridDim.x) {
        const int layer = item / 96, cb = item % 96, col = cb * 128 + cl * 4;
        const float* W = a.in[IN_MODW] + (size_t)layer * D * (6 * D) + col;
        f32x4 a0 = {0.f, 0.f, 0.f, 0.f}, a1 = {0.f, 0.f, 0.f, 0.f};
#pragma unroll 8
        for (int kk = 0; kk < 128; ++kk) { const int k = kg * 128 + kk; const f32x4 w = *(const f32x4*)(W + (size_t)k * (6 * D)); a0 += w * s0[k]; a1 += w * s1[k]; }
        LAS float* r = red + (kg * 32 + cl) * 8;
        r[0] = a0[0]; r[1] = a0[1]; r[2] = a0[2]; r[3] = a0[3]; r[4] = a1[0]; r[5] = a1[1]; r[6] = a1[2]; r[7] = a1[3];
        __syncthreads();
        if (tid < 256) {
            const int cond = tid >> 7, c = tid & 127; float s = 0.f;
#pragma unroll
            for (int g = 0; g < 16; ++g) s += red[(g * 32 + (c >> 2)) * 8 + cond * 4 + (c & 3)];
            const int n = cb * 128 + c;
            MOD[((size_t)layer * 2 + cond) * (6 * D) + n] = s + a.in[IN_MODB][layer * 6 * D + n];
        }
        __syncthreads();
    }
}
template <int MAP> __device__ __forceinline__ int map_row(int n0) {
    if (MAP == 0) return n0;
    if (MAP == 1) return 256 * (n0 / 128) + (n0 % 128);
    if (MAP == 2) return 256 * (n0 / 128) + 128 + (n0 % 128);
    return n0 < 4096 ? n0 : (n0 < 4128 ? 6144 + (n0 - 4096) : n0 - 32);
}
template <int MAP> __device__ __forceinline__ void transpose_job(const float* W, int K, int N, bf16* WT, LAS float* scr, int gw, int ngw, int lane) {
    const int nblk = N / 32, nitems = (K / 64) * nblk;
    for (int item = gw; item < nitems; item += ngw) {
        const int kb = item / nblk, nb = item % nblk, k0 = 64 * kb, n0 = 32 * nb;
#pragma unroll 8
        for (int i = 0; i < 32; ++i) { const int kk = 2 * i + (lane >> 5); scr[kk * 33 + (lane & 31)] = W[(size_t)(k0 + kk) * N + n0 + (lane & 31)]; }
        asm volatile("s_waitcnt lgkmcnt(0)" ::: "memory");
        const int c = lane & 7; const int r0 = map_row<MAP>(n0);
#pragma unroll
        for (int j = 0; j < 4; ++j) { const int n = (lane >> 3) + 8 * j; const LAS float* s = scr + (8 * c) * 33 + n;
            u32x4 o; o.x = cvt_pk_bf16(s[0 * 33], s[1 * 33]); o.y = cvt_pk_bf16(s[2 * 33], s[3 * 33]); o.z = cvt_pk_bf16(s[4 * 33], s[5 * 33]); o.w = cvt_pk_bf16(s[6 * 33], s[7 * 33]);
            *(u32x4*)(WT + (size_t)(r0 + n) * K + k0 + 8 * c) = o; }
        asm volatile("s_waitcnt lgkmcnt(0)" ::: "memory");
    }
}

__device__ __forceinline__ void norm_row(const float* src, const float* g, const float* sh, const float* sc, bf16* dst, float* copy_dst, int lane, f32x4 (&h)[8]) {
    f32x4 v[8]; float ss = 0.f;
#pragma unroll
    for (int j = 0; j < 8; ++j) { v[j] = *(const f32x4*)(src + 4 * lane + 256 * j); ss += (v[j][0] * v[j][0] + v[j][1] * v[j][1]) + (v[j][2] * v[j][2] + v[j][3] * v[j][3]); }
    if (copy_dst) {
#pragma unroll
        for (int j = 0; j < 8; ++j) *(f32x4*)(copy_dst + 4 * lane + 256 * j) = v[j];
    }
    const float rstd = 1.0f / sqrtf(wave_sum(ss) * (1.0f / D) + EPS);
#pragma unroll
    for (int j = 0; j < 8; ++j) { const int c = 4 * lane + 256 * j; const f32x4 gg = *(const f32x4*)(g + c), s1 = *(const f32x4*)(sc + c), s0 = *(const f32x4*)(sh + c);
        h[j] = (v[j] * rstd * gg) * (1.0f + s1) + s0;
        u32x2 w; w.x = cvt_pk_bf16(h[j][0], h[j][1]); w.y = cvt_pk_bf16(h[j][2], h[j][3]); *(u32x2*)(dst + c) = w; }
}

__device__ __forceinline__ void ev_prep_row(const Args& a, int r, int lane) {
    const bf16* PROJ = (const bf16*)(a.ws + WS_PROJ); const float* AUX = (const float*)(a.ws + WS_AUX);
    bf16* QN = (bf16*)(a.ws + WS_QN); bf16* KN = (bf16*)(a.ws + WS_KN); bf16* VC = (bf16*)(a.ws + WS_VC); bf16* XC = (bf16*)(a.ws + WS_XC);
    float* G = (float*)(a.ws + WS_GB); float* BETA = G + 16 * MT;
    const int lo = r < T ? 0 : T, hi = r < T ? T : MT;
#pragma unroll
    for (int it = 0; it < 6; ++it) {
        const int ch0 = (it * 64 + lane) * 8;
        float acc[8];
#pragma unroll
        for (int e = 0; e < 8; ++e) acc[e] = 0.f;
#pragma unroll
        for (int jj = 0; jj < 4; ++jj) { const int rr = r + jj - 2;
            if (rr >= lo && rr < hi) { float x[8]; unpack8(*(const u32x4*)(PROJ + (size_t)rr * NPROJ + ch0), x);
                const f32x4 w0 = *(const f32x4*)(a.in[IN_EVCONV] + jj * 3072 + ch0), w1 = *(const f32x4*)(a.in[IN_EVCONV] + jj * 3072 + ch0 + 4);
#pragma unroll
                for (int e = 0; e < 4; ++e) { acc[e] += x[e] * w0[e]; acc[4 + e] += x[4 + e] * w1[e]; } } }
        float ss = 0.f;
#pragma unroll
        for (int e = 0; e < 8; ++e) { acc[e] = siluf_(acc[e]); ss += acc[e] * acc[e]; }
        if (it < 4) { ss = sum16(ss); const float sc = (1.0f / sqrtf(ss + EPS)) * (it < 2 ? 0.08838834764831845f : 1.0f);
#pragma unroll
            for (int e = 0; e < 8; ++e) acc[e] *= sc; }
        bf16* dst = it < 2 ? QN + (size_t)r * 1024 + ch0 : (it < 4 ? KN + (size_t)r * 1024 + (ch0 - 1024) : VC + (size_t)r * 1024 + (ch0 - 2048));
        *(u32x4*)dst = pack8(acc);
    }
#pragma unroll
    for (int it = 0; it < 2; ++it) {
        const int ch0 = (it * 64 + lane) * 8;
        float acc[8];
        { const f32x4 b0 = *(const f32x4*)(a.in[IN_LCB] + ch0), b1 = *(const f32x4*)(a.in[IN_LCB] + ch0 + 4);
#pragma unroll
          for (int e = 0; e < 4; ++e) { acc[e] = b0[e]; acc[4 + e] = b1[e]; } }
#pragma unroll
        for (int jj = 0; jj < 4; ++jj) { const int rr = r + jj - 2;
            if (rr >= lo && rr < hi) { float x[8]; unpack8(*(const u32x4*)(PROJ + (size_t)rr * NPROJ + 4096 + ch0), x);
                const f32x4 w0 = *(const f32x4*)(a.in[IN_LCW] + jj * 1024 + ch0), w1 = *(const f32x4*)(a.in[IN_LCW] + jj * 1024 + ch0 + 4);
#pragma unroll
                for (int e = 0; e < 4; ++e) { acc[e] += x[e] * w0[e]; acc[4 + e] += x[4 + e] * w1[e]; } } }
        *(u32x4*)(XC + (size_t)r * 1024 + ch0) = pack8(acc);
    }
    if (lane < 16) {
        const float araw = AUX[(size_t)r * 32 + lane], braw = AUX[(size_t)r * 32 + 16 + lane];
        G[(size_t)lane * MT + r] = -expf(a.in[IN_ALOG][lane]) * softplusf_(araw + a.in[IN_DTB][lane]);
        BETA[(size_t)lane * MT + r] = sigmoidf_(braw);
    }
}

__device__ __forceinline__ void lru_gates_naive(const Args& a, LAS unsigned char* lds, int tid) {
    LAS float* xs = (LAS float*)lds;
    const bf16* XC = (const bf16*)(a.ws + WS_XC); bf16* LOGA = (bf16*)(a.ws + WS_LOGA); bf16* BIN = (bf16*)(a.ws + WS_BIN);
    const int m = tid & 127, rg = tid >> 7;
    for (int item = blockIdx.x; item < 2 * 8 * (MT / 64); item += gridDim.x) {
        const int rt = item % (MT / 64), dn = item / (MT / 64), n = dn % 8, d = dn / 8, r0 = rt * 64;
        for (int idx = tid; idx < 64 * 128; idx += NTHREADS) { const int row = idx >> 7, c = idx & 127; xs[row * 129 + c] = bf2f(XC[(size_t)(r0 + row) * 1024 + 128 * n + c]); }
        __syncthreads();
        float aA[16], aX[16];
#pragma unroll
        for (int i = 0; i < 16; ++i) { aA[i] = 0.f; aX[i] = 0.f; }
        const float* wa = a.in[IN_LWA] + ((size_t)(d * 8 + n) * 128) * 128 + m; const float* wx = a.in[IN_LWX] + ((size_t)(d * 8 + n) * 128) * 128 + m;
#pragma unroll 4
        for (int c = 0; c < 128; ++c) { const float va = wa[c * 128], vx = wx[c * 128];
#pragma unroll
            for (int i = 0; i < 16; ++i) { const float x = xs[(rg * 16 + i) * 129 + c]; aA[i] += x * va; aX[i] += x * vx; } }
        const int ch = 128 * n + m; const float ba = a.in[IN_LBA][d * 1024 + ch], bx = a.in[IN_LBX][d * 1024 + ch], sp = softplusf_(-a.in[IN_LAM][d * 1024 + ch]);
#pragma unroll
        for (int i = 0; i < 16; ++i) { const int row = rg * 16 + i; const float rr = sigmoidf_(aA[i] + ba), gi = sigmoidf_(aX[i] + bx), la = -8.0f * rr * sp;
            const float bin = sqrtf(-expm1f(2.0f * la)) * gi * xs[row * 129 + m];
            LOGA[((size_t)d * MT + r0 + row) * 1024 + ch] = f2bf(la); BIN[((size_t)d * MT + r0 + row) * 1024 + ch] = f2bf(bin); }
        __syncthreads();
    }
}

__device__ __forceinline__ int scan_row(int step, int d) { return step < CT ? T + (d ? CT - 1 - step : step) : (d ? T - 1 - (step - CT) : (step - CT)); }

__device__ __forceinline__ void dn_naive(const Args& a, LAS unsigned char* lds, int tid, int h, int d) {
    LAS float* st = (LAS float*)lds;
    LAS float* red = st + 512;
    LAS float* red2 = red + 512;
    const bf16* QN = (const bf16*)(a.ws + WS_QN); const bf16* KN = (const bf16*)(a.ws + WS_KN); const bf16* VC = (const bf16*)(a.ws + WS_VC);
    const float* G = (const float*)(a.ws + WS_GB); const float* BETA = G + 16 * MT; bf16* ODN = (bf16*)(a.ws + WS_ODN);
    const int j = tid & 127, qd = tid >> 7;
    float S[32];
#pragma unroll
    for (int i = 0; i < 32; ++i) S[i] = 0.f;
    const bf16* bsrc = tid < 128 ? KN + h * 128 + tid : (tid < 256 ? QN + h * 128 + (tid - 128) : VC + h * 128 + ((tid - 256) & 127));
    const float* fsrc = (tid == 384 ? G : BETA) + (size_t)(d * 8 + h) * MT;
#define DN_LD(step_) (tid < 384 ? bf2f(bsrc[(size_t)scan_row((step_), d) * 1024]) : (tid < 386 ? fsrc[scan_row((step_), d)] : 0.f))
    float cur = DN_LD(0);
    for (int step = 0; step < MT; ++step) {
        const int r = scan_row(step, d);
        st[tid] = cur;
        __syncthreads();
        if (step + 1 < MT) cur = DN_LD(step + 1);
        const float dec = expf(st[384]), beta = st[385];
        float p = 0.f;
#pragma unroll
        for (int i = 0; i < 32; ++i) { S[i] *= dec; p += st[32 * qd + i] * S[i]; }
        red[qd * 128 + j] = p;
        __syncthreads();
        const float ks = (red[j] + red[128 + j]) + (red[256 + j] + red[384 + j]);
        const float delta = beta * (st[256 + j] - ks);
        float p2 = 0.f;
#pragma unroll
        for (int i = 0; i < 32; ++i) { S[i] += st[32 * qd + i] * delta; p2 += st[128 + 32 * qd + i] * S[i]; }
        red2[qd * 128 + j] = p2;
        __syncthreads();
        if (qd == 0) ODN[((size_t)d * MT + r) * 1024 + h * 128 + j] = f2bf((red2[j] + red2[128 + j]) + (red2[256 + j] + red2[384 + j]));
    }
}
__device__ __forceinline__ void lru_naive(const Args& a, int id) {
    const int d = id >> 10, ch = id & 1023;
    const bf16* LOGA = (const bf16*)(a.ws + WS_LOGA) + (size_t)d * MT * 1024 + ch; const bf16* BIN = (const bf16*)(a.ws + WS_BIN) + (size_t)d * MT * 1024 + ch;
    bf16* HL = (bf16*)(a.ws + WS_HLRU) + (size_t)d * MT * 1024 + ch;
    float h = 0.f;
#pragma unroll 8
    for (int step = 0; step < MT; ++step) { const int r = scan_row(step, d);
        h = expf(bf2f(LOGA[(size_t)r * 1024])) * h + bf2f(BIN[(size_t)r * 1024]); HL[(size_t)r * 1024] = f2bf(h); }
}
__device__ __forceinline__ void ev_finish_row(const Args& a, int r, int lane) {
    const bf16* PROJ = (const bf16*)(a.ws + WS_PROJ); const bf16* ODN = (const bf16*)(a.ws + WS_ODN); const bf16* HL = (const bf16*)(a.ws + WS_HLRU); bf16* MIX = (bf16*)(a.ws + WS_MIX);
#pragma unroll
    for (int it = 0; it < 2; ++it) {
        const int ch0 = (it * 64 + lane) * 8;
        float o0[8], o1[8], z[8], o[8]; unpack8(*(const u32x4*)(ODN + (size_t)r * 1024 + ch0), o0); unpack8(*(const u32x4*)(ODN + ((size_t)MT + r) * 1024 + ch0), o1);
        unpack8(*(const u32x4*)(PROJ + (size_t)r * NPROJ + 3072 + ch0), z);
        float ss = 0.f;
#pragma unroll
        for (int e = 0; e < 8; ++e) { o[e] = o0[e] + o1[e]; ss += o[e] * o[e]; }
        ss = sum16(ss); const float rstd = 1.0f / sqrtf(ss * (1.0f / 128.0f) + EPS);
        const f32x4 g0 = *(const f32x4*)(a.in[IN_DNG] + (ch0 & 127)), g1 = *(const f32x4*)(a.in[IN_DNG] + (ch0 & 127) + 4);
#pragma unroll
        for (int e = 0; e < 4; ++e) { o[e] = o[e] * rstd * g0[e] * siluf_(z[e]); o[4 + e] = o[4 + e] * rstd * g1[e] * siluf_(z[4 + e]); }
        *(u32x4*)(MIX + (size_t)r * D + ch0) = pack8(o);
    }
#pragma unroll
    for (int it = 0; it < 2; ++it) {
        const int ch0 = (it * 64 + lane) * 8;
        float h0[8], h1[8], gr[8], y[8]; unpack8(*(const u32x4*)(HL + (size_t)r * 1024 + ch0), h0); unpack8(*(const u32x4*)(HL + ((size_t)MT + r) * 1024 + ch0), h1);
        unpack8(*(const u32x4*)(PROJ + (size_t)r * NPROJ + 5120 + ch0), gr);
#pragma unroll
        for (int e = 0; e < 8; ++e) y[e] = (h0[e] + h1[e]) * gelu_tanh(gr[e]);
        *(u32x4*)(MIX + (size_t)r * D + 1024 + ch0) = pack8(y);
    }
}
__device__ __forceinline__ void gla_naive(const Args& a, LAS unsigned char* lds, int tid, int h, int d, int qv) {
    LAS float* qs = (LAS float*)lds; LAS float* ks = qs + 256; LAS float* al = ks + 256; LAS float* vs = al + 256; LAS float* red = vs + 128;
    const bf16* PROJ = (const bf16*)(a.ws + WS_PROJ); const float* AUX = (const float*)(a.ws + WS_AUX); bf16* OG = (bf16*)(a.ws + WS_OGLA);
    const int j = tid & 127, qd = tid >> 7;
    float S[64];
#pragma unroll
    for (int i = 0; i < 64; ++i) S[i] = 0.f;
    float wg[16]; float bgc = 0.f;
    if (tid < 256) { const int ch = h * 256 + tid; bgc = a.in[IN_BG][d * 1024 + ch];
#pragma unroll
        for (int rr = 0; rr < 16; ++rr) wg[rr] = a.in[IN_WG2][(size_t)(d * 16 + rr) * 1024 + ch]; }
    else {
#pragma unroll
        for (int rr = 0; rr < 16; ++rr) wg[rr] = 0.f; }
    for (int step = 0; step < MT; ++step) {
        const int row = scan_row(step, d);
        if (tid < 256) { const int ch = h * 256 + tid;
            qs[tid] = bf2f(PROJ[(size_t)row * NPROJ + ch]) * 0.0625f; ks[tid] = bf2f(PROJ[(size_t)row * NPROJ + 1024 + ch]);
            float lg = bgc; const float* gd = AUX + (size_t)row * 32 + d * 16;
#pragma unroll
            for (int rr = 0; rr < 16; ++rr) lg += gd[rr] * wg[rr];
            const float ls = fminf(lg, 0.f) - log1pf(expf(-fabsf(lg)));
            al[tid] = expf(ls * 0.0625f);
        } else if (tid < 384) vs[tid - 256] = bf2f(PROJ[(size_t)row * NPROJ + 2048 + h * 512 + qv * 128 + (tid - 256)]);
        __syncthreads();
        const float v = vs[j]; float p = 0.f;
#pragma unroll
        for (int i = 0; i < 64; ++i) { const int dk = 64 * qd + i; S[i] = al[dk] * S[i] + ks[dk] * v; p += qs[dk] * S[i]; }
        red[qd * 128 + j] = p;
        __syncthreads();
        if (qd == 0 && row < T) OG[((size_t)d * T + row) * D + h * 512 + qv * 128 + j] = f2bf((red[j] + red[128 + j]) + (red[256 + j] + red[384 + j]));
    }
}
__device__ __forceinline__ void od_finish_row(const Args& a, int n, int lane) {
    const int p = (n & 63) * 256 + (n >> 6);
    const bf16* PROJ = (const bf16*)(a.ws + WS_PROJ); const bf16* OG = (const bf16*)(a.ws + WS_OGLA); bf16* MIX = (bf16*)(a.ws + WS_MIX);
#pragma unroll
    for (int it = 0; it < 4; ++it) {
        const int ch0 = it * 512 + lane * 8;
        float o0[8], o1[8], go[8], o[8]; unpack8(*(const u32x4*)(OG + (size_t)p * D + ch0), o0); unpack8(*(const u32x4*)(OG + ((size_t)T + p) * D + ch0), o1);
        unpack8(*(const u32x4*)(PROJ + (size_t)p * NPROJ + 4096 + ch0), go);
        float ss = 0.f;
#pragma unroll
        for (int e = 0; e < 8; ++e) { o[e] = o0[e] + o1[e]; ss += o[e] * o[e]; }
        ss = wave_sum(ss); const float rstd = 1.0f / sqrtf(ss * (1.0f / 512.0f) + EPS);
        const f32x4 g0 = *(const f32x4*)(a.in[IN_GLAG] + lane * 8), g1 = *(const f32x4*)(a.in[IN_GLAG] + lane * 8 + 4);
#pragma unroll
        for (int e = 0; e < 4; ++e) { o[e] = o[e] * rstd * g0[e] * siluf_(go[e]); o[4 + e] = o[4 + e] * rstd * g1[e] * siluf_(go[4 + e]); }
        *(u32x4*)(MIX + (size_t)n * D + ch0) = pack8(o);
    }
}

__global__ void __launch_bounds__(NTHREADS, 2) fwd_kernel(Args args) {
    extern __shared__ __attribute__((aligned(16))) unsigned char lds_raw[];
    LAS unsigned char* lds = (LAS unsigned char*)lds_raw;
    const int tid = threadIdx.x, lane = tid & 63, wave = __builtin_amdgcn_readfirstlane(tid >> 6);
    const int G = gridDim.x, gw = blockIdx.x * NWAVES + wave, NGW = G * NWAVES;
    unsigned char* ws = args.ws;
    unsigned* ctl = (unsigned*)(ws + WS_CTL);
    volatile LAS unsigned* MISC = (volatile LAS unsigned*)(lds + LDSCTL_OFF);
    for (int u = tid; u < (LDS_BYTES - LDSCTL_OFF) / 4; u += NTHREADS) ((LAS unsigned*)(lds + LDSCTL_OFF))[u] = 0u;
    __syncthreads();
#if MK_ONE_LAUNCH
    XcdBarrier bar = xcd_barrier_post(ctl + CW_BAR, MISC + 8);
#define GRID_BAR() xcd_barrier(bar)
#else
#define GRID_BAR() do {} while (0)
#endif
    const int lo = args.ph_lo, hi = args.ph_hi;
#define IN(k) (lo <= (k) && (k) < hi)
#define BOTH(k) (IN(k) && IN((k) + 1))
    float* MOD = (float*)(ws + WS_MOD);
#define MODV(layer, cond, j) (MOD + (((layer) * 2 + (cond)) * 6 + (j)) * D)
    float* XRES = (float*)(ws + WS_XRES);
    bf16* H = (bf16*)(ws + WS_H);
    bf16* MIX = (bf16*)(ws + WS_MIX);

    if (IN(0)) {
        p0_adaln(args, lds, tid);
        LAS float* scr = (LAS float*)(lds + wave * 16384);
        transpose_job<3>(args.in[IN_EVWIN], D, EV_IN, (bf16*)(ws + WS_W_EVIN), scr, gw, NGW, lane);
        transpose_job<0>(args.in[IN_EVWOUT], D, D, (bf16*)(ws + WS_W_EVOUT), scr, gw, NGW, lane);
        transpose_job<1>(args.in[IN_EVGATE], D, FF, (bf16*)(ws + WS_W_EVGU), scr, gw, NGW, lane);
        transpose_job<2>(args.in[IN_EVUP], D, FF, (bf16*)(ws + WS_W_EVGU), scr, gw, NGW, lane);
        transpose_job<0>(args.in[IN_EVDOWN], FF, D, (bf16*)(ws + WS_W_EVDN), scr, gw, NGW, lane);
        transpose_job<0>(args.in[IN_ODWIN], D, EV_IN, (bf16*)(ws + WS_W_ODIN), scr, gw, NGW, lane);
        transpose_job<0>(args.in[IN_ODWOUT], D, D, (bf16*)(ws + WS_W_ODOUT), scr, gw, NGW, lane);
        for (int e = 0; e < NEXP; ++e) {
            transpose_job<1>(args.in[IN_XGATE] + (size_t)e * D * FF, D, FF, (bf16*)(ws + WS_W_XGU) + (size_t)e * 2 * FF * D, scr, gw, NGW, lane);
            transpose_job<2>(args.in[IN_XUP] + (size_t)e * D * FF, D, FF, (bf16*)(ws + WS_W_XGU) + (size_t)e * 2 * FF * D, scr, gw, NGW, lane);
            transpose_job<0>(args.in[IN_XDOWN] + (size_t)e * FF * D, FF, D, (bf16*)(ws + WS_W_XDN) + (size_t)e * D * FF, scr, gw, NGW, lane);
        }
        if (BOTH(0)) GRID_BAR();
    }
    if (IN(1)) {
        for (int r = gw; r < MT; r += NGW) { const int cond = r >= T; f32x4 hv[8];
            const float* src = cond ? args.in[IN_CTX] + (size_t)(r - T) * D : args.in[IN_X] + (size_t)r * D;
            norm_row(src, args.in[IN_N1G], MODV(0, cond, 0), MODV(0, cond, 1), H + (size_t)r * D, XRES + (size_t)r * D, lane, hv); }
        if (BOTH(1)) GRID_BAR();
    }
    if (IN(2)) {
        pg8::Gemm g{H, (const bf16*)(ws + WS_W_EVIN), MT, NPROJ_PAD, D}; pg8::StaticOrder S; S.init(MT, NPROJ_PAD, G, (int)blockIdx.x);
        pg8::EpiProj E{(bf16*)(ws + WS_PROJ), (float*)(ws + WS_AUX), NPROJ, NPROJ / 256};
        pg8::gemm_phase<pg8::EpiProj, pg8::StaticOrder, true, true>(lds, g, S, E);
        if (BOTH(2)) GRID_BAR();
    }
    if (IN(3)) {
        for (int r = gw; r < MT; r += NGW) ev_prep_row(args, r, lane);
        if (BOTH(3)) GRID_BAR();
    }
    if (IN(4)) {
        lru_gates_naive(args, lds, tid);
        if (BOTH(4)) GRID_BAR();
    }
    if (IN(5)) {
        const int b = blockIdx.x;
        if (b < 16) dn_naive(args, lds, tid, b & 7, b >> 3);
        else if (b < 20) lru_naive(args, (b - 16) * NTHREADS + tid);
        if (BOTH(5)) GRID_BAR();
    }
    if (IN(6)) {
        for (int r = gw; r < MT; r += NGW) ev_finish_row(args, r, lane);
        if (BOTH(6)) GRID_BAR();
    }
    if (IN(7)) {
        pg8::Gemm g{MIX, (const bf16*)(ws + WS_W_EVOUT), MT, D, D}; pg8::StaticOrder S; S.init(MT, D, G, (int)blockIdx.x);
        pg8::EpiResid E{XRES, MODV(0, 0, 2), MODV(0, 1, 2)};
        pg8::gemm_phase<pg8::EpiResid, pg8::StaticOrder, true, true>(lds, g, S, E);
        if (BOTH(7)) GRID_BAR();
    }
    if (IN(8)) {
        for (int r = gw; r < MT; r += NGW) { const int cond = r >= T; f32x4 hv[8];
            norm_row(XRES + (size_t)r * D, args.in[IN_N2G], MODV(0, cond, 3), MODV(0, cond, 4), H + (size_t)r * D, nullptr, lane, hv); }
        if (BOTH(8)) GRID_BAR();
    }
    if (IN(9)) {
        pg8::Gemm g{H, (const bf16*)(ws + WS_W_EVGU), MT, 2 * FF, D}; pg8::StaticOrder S; S.init(MT, 2 * FF, G, (int)blockIdx.x);
        pg8::EpiSwiglu E{(bf16*)(ws + WS_HID), FF, 2 * FF / 256};
        pg8::gemm_phase<pg8::EpiSwiglu, pg8::StaticOrder, true, true>(lds, g, S, E);
        if (BOTH(9)) GRID_BAR();
    }
    if (IN(10)) {
        pg8::Gemm g{(const bf16*)(ws + WS_HID), (const bf16*)(ws + WS_W_EVDN), MT, D, FF}; pg8::StaticOrder S; S.init(MT, D, G, (int)blockIdx.x);
        pg8::EpiResid E{XRES, MODV(0, 0, 5), MODV(0, 1, 5)};
        pg8::gemm_phase<pg8::EpiResid, pg8::StaticOrder, true, true>(lds, g, S, E);
        if (BOTH(10)) GRID_BAR();
    }
    if (IN(11)) {
        for (int r = gw; r < MT; r += NGW) { const int cond = r >= T; f32x4 hv[8];
            const int dstr = cond ? r : ((r & 63) * 256 + (r >> 6));
            norm_row(XRES + (size_t)r * D, args.in[IN_N1G] + D, MODV(1, cond, 0), MODV(1, cond, 1), H + (size_t)dstr * D, nullptr, lane, hv); }
        if (BOTH(11)) GRID_BAR();
    }
    if (IN(12)) {
        pg8::Gemm g{H, (const bf16*)(ws + WS_W_ODIN), MT, NPROJ_PAD, D}; pg8::StaticOrder S; S.init(MT, NPROJ_PAD, G, (int)blockIdx.x);
        pg8::EpiProj E{(bf16*)(ws + WS_PROJ), (float*)(ws + WS_AUX), NPROJ, NPROJ / 256};
        pg8::gemm_phase<pg8::EpiProj, pg8::StaticOrder, true, true>(lds, g, S, E);
        if (BOTH(12)) GRID_BAR();
    }
    if (IN(13)) {
        const int b = blockIdx.x;
        if (b < 32) gla_naive(args, lds, tid, (b >> 2) & 3, b >> 4, b & 3);
        if (BOTH(13)) GRID_BAR();
    }
    if (IN(14)) {
        for (int n = gw; n < T; n += NGW) od_finish_row(args, n, lane);
        if (BOTH(14)) GRID_BAR();
    }
    if (IN(15)) {
        pg8::Gemm g{MIX, (const bf16*)(ws + WS_W_ODOUT), T, D, D}; pg8::StaticOrder S; S.init(T, D, G, (int)blockIdx.x);
        pg8::EpiResid E{XRES, MODV(1, 0, 2), MODV(1, 1, 2)};
        pg8::gemm_phase<pg8::EpiResid, pg8::StaticOrder, true, true>(lds, g, S, E);
        if (BOTH(15)) GRID_BAR();
    }
    int* TOPI = (int*)(ws + WS_SMALL + SM_TOPI); float* TOPW = (float*)(ws + WS_SMALL + SM_TOPW); int* POS = (int*)(ws + WS_SMALL + SM_POS);
    int* SLOT = (int*)(ws + WS_SMALL + SM_SLOT); int* WGBASE = (int*)(ws + WS_SMALL + SM_WGBASE);
    if (IN(16)) {
        LAS int* hist = (LAS int*)lds;
        if (tid < 8) hist[tid] = 0;
        __syncthreads();
        for (int n = gw; n < T; n += NGW) { f32x4 hv[8];
            norm_row(XRES + (size_t)n * D, args.in[IN_N2G] + D, MODV(1, 0, 3), MODV(1, 0, 4), H + (size_t)n * D, nullptr, lane, hv);
            float lg[8];
#pragma unroll
            for (int e = 0; e < 8; ++e) lg[e] = 0.f;
#pragma unroll
            for (int j = 0; j < 8; ++j)
#pragma unroll
                for (int q = 0; q < 4; ++q) { const int c = 4 * lane + 256 * j + q; const f32x4 w0 = *(const f32x4*)(args.in[IN_RW] + (size_t)c * 8), w1 = *(const f32x4*)(args.in[IN_RW] + (size_t)c * 8 + 4);
                    const float x = hv[j][q];
#pragma unroll
                    for (int e = 0; e < 4; ++e) { lg[e] += x * w0[e]; lg[4 + e] += x * w1[e]; } }
#pragma unroll
            for (int e = 0; e < 8; ++e) lg[e] = wave_sum(lg[e]) + args.in[IN_RB][e];
            if (lane == 0) {
                int i0 = 0; float l0 = lg[0];
#pragma unroll
                for (int e = 1; e < 8; ++e) if (lg[e] > l0) { l0 = lg[e]; i0 = e; }
                int i1 = -1; float l1 = -3.0e38f;
#pragma unroll
                for (int e = 0; e < 8; ++e) if (e != i0 && lg[e] > l1) { l1 = lg[e]; i1 = e; }
                const float w0 = 1.0f / (1.0f + expf(l1 - l0));
                TOPI[2 * n] = i0; TOPI[2 * n + 1] = i1; TOPW[2 * n] = w0; TOPW[2 * n + 1] = 1.0f - w0;
                POS[2 * n] = __hip_atomic_fetch_add(hist + i0, 1, __ATOMIC_RELAXED, __HIP_MEMORY_SCOPE_WORKGROUP); POS[2 * n + 1] = __hip_atomic_fetch_add(hist + i1, 1, __ATOMIC_RELAXED, __HIP_MEMORY_SCOPE_WORKGROUP);
            }
        }
        __syncthreads();
        if (tid < 8) WGBASE[blockIdx.x * 8 + tid] = (int)atomicAdd(ctl + CW_CNT + tid, (unsigned)hist[tid]);
        if (BOTH(16)) GRID_BAR();
    }
    int tend[8]; int Mt = 0; int pstart[8];
    if (hi > 17) {
#pragma unroll
        for (int e = 0; e < 8; ++e) { const int c = (int)__hip_atomic_load(ctl + CW_CNT + e, __ATOMIC_RELAXED, __HIP_MEMORY_SCOPE_AGENT); pstart[e] = Mt * 256; Mt += (c + 255) >> 8; tend[e] = Mt; }
    }
    if (IN(17)) {
        bf16* XS = (bf16*)(ws + WS_XS);
        for (int n = gw; n < T; n += NGW) {
#pragma unroll
            for (int k = 0; k < 2; ++k) { const int e = TOPI[2 * n + k]; int ps = 0;
#pragma unroll
                for (int q = 0; q < 8; ++q) ps = (q == e) ? pstart[q] : ps;
                const int slot = ps + WGBASE[blockIdx.x * 8 + e] + POS[2 * n + k];
                if (lane == 0) SLOT[2 * n + k] = slot;
                const u32x4* s = (const u32x4*)(H + (size_t)n * D); u32x4* dptr = (u32x4*)(XS + (size_t)slot * D);
#pragma unroll
                for (int q = 0; q < 4; ++q) dptr[lane + 64 * q] = s[lane + 64 * q]; }
        }
        if (BOTH(17)) GRID_BAR();
    }
    if (IN(18)) {
        pg8::Gemm g{(const bf16*)(ws + WS_XS), (const bf16*)(ws + WS_W_XGU), Mt * 256, 2 * FF, D};
        pg8::MoeOrder S; S.nN = 2 * FF / 256; S.Mt = Mt; S.nwg = Mt * S.nN; S.G = G; S.c = (int)blockIdx.x;
#pragma unroll
        for (int e = 0; e < 8; ++e) S.tend[e] = tend[e];
        pg8::EpiSwiglu E{(bf16*)(ws + WS_HID2), FF, 2 * FF / 256};
        pg8::gemm_phase<pg8::EpiSwiglu, pg8::MoeOrder, true, true>(lds, g, S, E);
        if (BOTH(18)) GRID_BAR();
    }
    if (IN(19)) {
        pg8::Gemm g{(const bf16*)(ws + WS_HID2), (const bf16*)(ws + WS_W_XDN), Mt * 256, D, FF};
        pg8::MoeOrder S; S.nN = D / 256; S.Mt = Mt; S.nwg = Mt * S.nN; S.G = G; S.c = (int)blockIdx.x;
#pragma unroll
        for (int e = 0; e < 8; ++e) S.tend[e] = tend[e];
        pg8::EpiBf16N E{(bf16*)(ws + WS_YB), D, D / 256};
        pg8::gemm_phase<pg8::EpiBf16N, pg8::MoeOrder, true, true>(lds, g, S, E);
        if (BOTH(19)) GRID_BAR();
    }
    if (IN(20)) {
        const bf16* YB = (const bf16*)(ws + WS_YB); const float* gt2 = MODV(1, 0, 5);
        for (int n = gw; n < T; n += NGW) {
            const int s0 = SLOT[2 * n], s1 = SLOT[2 * n + 1]; const float w0 = TOPW[2 * n], w1 = TOPW[2 * n + 1];
            f32x4 v[8]; float ss = 0.f;
#pragma unroll
            for (int j = 0; j < 8; ++j) { const int c = 4 * lane + 256 * j;
                const u32x2 a0 = *(const u32x2*)(YB + (size_t)s0 * D + c), a1 = *(const u32x2*)(YB + (size_t)s1 * D + c);
                f32x4 y; y[0] = w0 * bf2f(a0.x & 0xffffu) + w1 * bf2f(a1.x & 0xffffu); y[1] = w0 * bf2f(a0.x >> 16) + w1 * bf2f(a1.x >> 16);
                y[2] = w0 * bf2f(a0.y & 0xffffu) + w1 * bf2f(a1.y & 0xffffu); y[3] = w0 * bf2f(a0.y >> 16) + w1 * bf2f(a1.y >> 16);
                v[j] = *(const f32x4*)(XRES + (size_t)n * D + c) + *(const f32x4*)(gt2 + c) * y;
                ss += (v[j][0] * v[j][0] + v[j][1] * v[j][1]) + (v[j][2] * v[j][2] + v[j][3] * v[j][3]); }
            const float rstd = 1.0f / sqrtf(wave_sum(ss) * (1.0f / D) + EPS);
#pragma unroll
            for (int j = 0; j < 8; ++j) { const int c = 4 * lane + 256 * j; *(f32x4*)(args.out + (size_t)n * D + c) = v[j] * rstd * *(const f32x4*)(args.in[IN_FNG] + c); }
        }
    }
#undef IN
#undef BOTH
}

extern "C" void kernel_launch(void* const* d_in, const int* in_sizes, int n_in, void* d_out, int out_size, void* d_ws, size_t ws_size, hipStream_t stream) {
    static int grid = 0;
    if (grid == 0) {
        if (n_in != N_IN || out_size != T * D || ws_size < (WS_END > WS_L0_END ? WS_END : WS_L0_END)) { fprintf(stderr, "kernel_launch: unexpected shapes (n_in %d, out %d, ws %zu)\n", n_in, out_size, ws_size); grid = -1; return; }
        int dev = 0, cus = 0, per_cu = 0;
        if (hipGetDevice(&dev) != hipSuccess || hipDeviceGetAttribute(&cus, hipDeviceAttributeMultiprocessorCount, dev) != hipSuccess) { grid = -1; return; }
        if (hipFuncSetAttribute((const void*)fwd_kernel, hipFuncAttributeMaxDynamicSharedMemorySize, LDS_BYTES) != hipSuccess) { fprintf(stderr, "kernel_launch: hipFuncSetAttribute failed\n"); grid = -1; return; }
        if (hipOccupancyMaxActiveBlocksPerMultiprocessor(&per_cu, (const void*)fwd_kernel, NTHREADS, LDS_BYTES) != hipSuccess || per_cu < 1) fprintf(stderr, "kernel_launch: occupancy query says %d\n", per_cu);
        (void)hipGetLastError();
        grid = cus;
    }
    if (grid < 0) return;
    (void)hipMemsetAsync((char*)d_ws + WS_CTL, 0, CTL_BYTES, stream);
    Args a{};
    for (int i = 0; i < N_IN; ++i) a.in[i] = (const float*)d_in[i];
    a.out = (float*)d_out; a.ws = (unsigned char*)d_ws;
#if MK_ONE_LAUNCH
    a.ph_lo = 0; a.ph_hi = N_PHASES;
    hipLaunchKernelGGL(fwd_kernel, dim3(grid), dim3(NTHREADS), LDS_BYTES, stream, a);
#else
    for (int p = 0; p < N_PHASES; ++p) { a.ph_lo = p; a.ph_hi = p + 1; hipLaunchKernelGGL(fwd_kernel, dim3(grid), dim3(NTHREADS), LDS_BYTES, stream, a); }
#endif
}
```

```cpp
#include <hip/hip_runtime.h>
#include <cstdio>
#include <cstdint>

#define GAS __attribute__((address_space(1)))
#define LAS __attribute__((address_space(3)))
typedef unsigned short bf16;
typedef float f32x4 __attribute__((ext_vector_type(4)));
typedef float f32x2 __attribute__((ext_vector_type(2)));
typedef unsigned u32x4 __attribute__((ext_vector_type(4)));
typedef unsigned u32x2 __attribute__((ext_vector_type(2)));
typedef short bf16x8 __attribute__((ext_vector_type(8)));

constexpr int D = 2048, T = 16384, CT = 256, MT = T + CT, FF = 5632;
constexpr int NPROJ = 6144, NPROJ_PAD = 6400, EV_IN = 6176;
constexpr int NEXP = 8;
constexpr float EPS = 1e-6f;
constexpr int XS_ROWS = 34816;

constexpr size_t MiB = 1u << 20;
constexpr size_t WS_CTL = 0, CTL_BYTES = 1 * MiB;
constexpr size_t WS_MOD = 1 * MiB;
constexpr size_t WS_SMALL = 2 * MiB;
constexpr size_t WS_W_EVIN = 4 * MiB;
constexpr size_t WS_W_EVOUT = WS_W_EVIN + 25 * MiB;
constexpr size_t WS_W_EVGU = WS_W_EVOUT + 8 * MiB;
constexpr size_t WS_W_EVDN = WS_W_EVGU + 44 * MiB;
constexpr size_t WS_W_ODIN = WS_W_EVDN + 22 * MiB;
constexpr size_t WS_W_ODOUT = WS_W_ODIN + 25 * MiB;
constexpr size_t WS_W_XGU = WS_W_ODOUT + 8 * MiB;
constexpr size_t WS_W_XDN = WS_W_XGU + 352 * MiB;
constexpr size_t WS_XRES = WS_W_XDN + 176 * MiB;
constexpr size_t WS_H = WS_XRES + 130 * MiB;
constexpr size_t WS_S = WS_H + 65 * MiB;
constexpr size_t WS_PROJ = WS_S;
constexpr size_t WS_AUX = WS_S + 195 * MiB;
constexpr size_t WS_QN = WS_AUX + 3 * MiB;
constexpr size_t WS_KN = WS_QN + 33 * MiB;
constexpr size_t WS_VC = WS_KN + 33 * MiB;
constexpr size_t WS_XC = WS_VC + 33 * MiB;
constexpr size_t WS_GB = WS_XC + 33 * MiB;
constexpr size_t WS_HLOC = WS_GB + 5 * MiB;
constexpr size_t WS_CL = WS_HLOC + 65 * MiB;
constexpr size_t WS_ODN = WS_CL + 65 * MiB;
constexpr size_t WS_LAGG = WS_ODN + 65 * MiB;
constexpr size_t WS_MIX = WS_H;
constexpr size_t WS_DNB = WS_LAGG + 7 * MiB;
constexpr size_t WS_L0_END = WS_DNB + 230 * MiB;
constexpr size_t WS_HID = WS_S;
constexpr size_t WS_OGLA = WS_QN;
constexpr size_t WS_GLB = WS_OGLA + 128 * MiB;
constexpr size_t WS_GLZ = WS_GLB + 149 * MiB;
static_assert(WS_GLZ + 33 * MiB <= 1640 * MiB, "GLA blobs");
constexpr size_t WS_HID2 = WS_S;
constexpr size_t WS_XS = WS_S + 374 * MiB;
constexpr size_t WS_YB = WS_XS + 136 * MiB;
constexpr size_t WS_YBX = WS_YB + 136 * MiB;
constexpr size_t WS_END = WS_YBX + 64 * MiB;
static_assert(WS_L0_END <= 1640 * MiB && WS_END <= 1640 * MiB, "workspace map");
constexpr size_t SM_TOPI = 0;
constexpr size_t SM_TOPW = 128 * 1024;
constexpr size_t SM_POS = 256 * 1024;
constexpr size_t SM_SLOT = 384 * 1024;
constexpr size_t SM_WGBASE = 512 * 1024;
constexpr size_t SM_ROWMAP = 640 * 1024;
constexpr size_t SM_WVPRE = 800 * 1024;
constexpr size_t SM_WGCNT = 896 * 1024;
constexpr size_t SM_LRUW = 1024 * 1024;
constexpr int CW_CNT = 64;
constexpr int CW_BAR = 4096;

__device__ __forceinline__ float bf2f(unsigned b) { return __uint_as_float(b << 16); }
typedef __bf16 bf16v2_t __attribute__((ext_vector_type(2)));
__device__ __forceinline__ unsigned cvt_pk_bf16(float lo, float hi) { const f32x2 v = {lo, hi}; return __builtin_bit_cast(unsigned, __builtin_convertvector(v, bf16v2_t)); }
__device__ __forceinline__ unsigned short f2bf(float f) { return (unsigned short)(cvt_pk_bf16(f, 0.f) & 0xffffu); }
__device__ __forceinline__ void unpack8(const u32x4 w, float (&o)[8]) {
    o[0] = __uint_as_float(w.x << 16); o[1] = __uint_as_float(w.x & 0xffff0000u); o[2] = __uint_as_float(w.y << 16); o[3] = __uint_as_float(w.y & 0xffff0000u);
    o[4] = __uint_as_float(w.z << 16); o[5] = __uint_as_float(w.z & 0xffff0000u); o[6] = __uint_as_float(w.w << 16); o[7] = __uint_as_float(w.w & 0xffff0000u);
}
__device__ __forceinline__ u32x4 pack8(const float (&v)[8]) { u32x4 w; w.x = cvt_pk_bf16(v[0], v[1]); w.y = cvt_pk_bf16(v[2], v[3]); w.z = cvt_pk_bf16(v[4], v[5]); w.w = cvt_pk_bf16(v[6], v[7]); return w; }
__device__ __forceinline__ float fexp(float x) { return __builtin_amdgcn_exp2f(x * 1.4426950408889634f); }
__device__ __forceinline__ float flog(float x) { return __builtin_amdgcn_logf(x) * 0.6931471805599453f; }
__device__ __forceinline__ float frcp(float x) { return __builtin_amdgcn_rcpf(x); }
__device__ __forceinline__ float sigmoidf_(float x) { return frcp(1.0f + fexp(-x)); }
__device__ __forceinline__ float siluf_(float x) { return x * frcp(1.0f + fexp(-x)); }
__device__ __forceinline__ float softplusf_(float x) { return fmaxf(x, 0.f) + flog(1.0f + fexp(-fabsf(x))); }
__device__ __forceinline__ float gelu_tanh(float x) { const float u = 0.7978845608028654f * (x + 0.044715f * x * x * x); return x * frcp(1.0f + fexp(-2.0f * u)); }
__device__ __forceinline__ float wave_sum(float v) {
#pragma unroll
    for (int o = 1; o < 64; o <<= 1) v += __shfl_xor(v, o);
    return v;
}
__device__ __forceinline__ float sum16(float v) {
#pragma unroll
    for (int o = 1; o < 16; o <<= 1) v += __shfl_xor(v, o);
    return v;
}

namespace pg8 {
#define PG8_LAS __attribute__((address_space(3)))
typedef unsigned short bf16_t;
constexpr int BM = 256, BK = 64, HALF = 128, HTB = HALF * BK * 2, STAGE_BYTES = 8 * HTB, NXCD = 8, WGM = 8;
__host__ __device__ __forceinline__ int lds_byte(int r, int c) { const int st = (r >> 4) * 2 + (c >> 5), rr = r & 15, cc = c & 31, ob = rr * 64 + cc * 2; return st * 1024 + (ob ^ (((ob >> 9) & 1) << 5)); }
__host__ __device__ __forceinline__ void stage_rc(int b, int& R, int& C) { const int st = b / 1024, sb = b % 1024, swz = sb ^ (((sb >> 9) & 1) << 5); R = (st >> 1) * 16 + swz / 64; C = (st & 1) * 32 + (swz % 64) / 2; }
__host__ __device__ __forceinline__ int perm32(int rho) { const int n = rho >> 4, i = rho & 15; return 8 * (i >> 2) + 4 * n + (i & 3); }

struct Unit { int pm, pn, ko; };
struct Gemm { const bf16_t* A; const bf16_t* Bt; int M, N, K, ld; };

struct StaticOrder {
    int nM, nN, nwg, G, c;
    __host__ __device__ void init(int M, int N, int G_, int c_) { nM = M / BM; nN = N / BM; nwg = nM * nN; G = G_; c = c_; }
    __host__ __device__ bool next(int i, Unit& u) const {
        const long L = (long)i * G + c; if (L >= nwg) return false;
        int wgid = (int)L; { const int q = nwg / NXCD, r = nwg % NXCD, xcd = wgid % NXCD, off = wgid / NXCD; wgid = (xcd < r ? xcd * (q + 1) : r * (q + 1) + (xcd - r) * q) + off; }
        const int nig = WGM * nN, gid = wgid / nig, fm = gid * WGM, gsz = (nM - fm) < WGM ? (nM - fm) : WGM;
        u.pm = fm + ((wgid % nig) % gsz); u.pn = (wgid % nig) / gsz; u.ko = 0; return true;
    }
    __device__ __forceinline__ void a_ready(const Unit&) const {}
    __device__ __forceinline__ void done(const Unit&) const {}
};
struct MoeOrder {
    int nN, Mt, nwg, G, c; int tend[8];
    __device__ bool next(int i, Unit& u) const {
        const long L = (long)i * G + c; if (L >= nwg) return false;
        int wgid = (int)L; { const int q = nwg / NXCD, r = nwg % NXCD, xcd = wgid % NXCD, off = wgid / NXCD; wgid = (xcd < r ? xcd * (q + 1) : r * (q + 1) + (xcd - r) * q) + off; }
        const int nig = WGM * nN, gid = wgid / nig, fm = gid * WGM, gsz = (Mt - fm) < WGM ? (Mt - fm) : WGM;
        const int pm = fm + ((wgid % nig) % gsz), pnl = (wgid % nig) / gsz;
        int e = 0;
#pragma unroll
        for (int j = 0; j < 7; ++j) e += (pm >= tend[j]) ? 1 : 0;
        u.pm = pm; u.pn = e * nN + pnl; u.ko = 0; return true;
    }
    __device__ __forceinline__ void a_ready(const Unit&) const {}
    __device__ __forceinline__ void done(const Unit&) const {}
};

struct EpiProj {
    static constexpr bool PERM = true, AFTER_DRAIN = false;
    bf16_t* O; float* AUX; int ldc, npn;
    __device__ __forceinline__ void operator()(const f32x4 (&acc)[2][2][4][2], const Unit& u, int wr, int wc, int fr, int fq) const {
        const int row0 = u.pm * BM + wr * 64 + fr;
        if (u.pn < npn) {
            const int col0 = u.pn * BM + wc * 32 + 8 * fq;
#pragma unroll
            for (int ai = 0; ai < 2; ++ai)
#pragma unroll
                for (int m = 0; m < 4; ++m) { bf16_t* rowp = O + (size_t)(row0 + ai * HALF + m * 16) * ldc + col0;
#pragma unroll
                    for (int bj = 0; bj < 2; ++bj) { const f32x4 v0 = acc[ai][bj][m][0], v1 = acc[ai][bj][m][1];
                        u32x4 w; w.x = cvt_pk_bf16(v0[0], v0[1]); w.y = cvt_pk_bf16(v0[2], v0[3]); w.z = cvt_pk_bf16(v1[0], v1[1]); w.w = cvt_pk_bf16(v1[2], v1[3]);
                        *(u32x4*)(rowp + bj * HALF) = w; } }
        } else if (wc == 0) {
#pragma unroll
            for (int ai = 0; ai < 2; ++ai)
#pragma unroll
                for (int m = 0; m < 4; ++m) { float* rowp = AUX + (size_t)(row0 + ai * HALF + m * 16) * 32 + 8 * fq;
                    *(f32x4*)(rowp) = acc[ai][0][m][0]; *(f32x4*)(rowp + 4) = acc[ai][0][m][1]; }
        }
    }
};
struct EpiResid {
    static constexpr bool PERM = false, AFTER_DRAIN = false;
    float* X; const float* gate_lat; const float* gate_ctx; const float* base_lat; const float* base_ctx;
    __device__ __forceinline__ void operator()(const f32x4 (&acc)[2][2][4][2], const Unit& u, int wr, int wc, int fr, int fq) const {
        const float* gate = (u.pm >= 64) ? gate_ctx : gate_lat;
        const int row0 = u.pm * BM + wr * 64 + fr, col0 = u.pn * BM + wc * 32 + 4 * fq;
        const float* Bp = base_lat ? ((u.pm >= 64) ? base_ctx - (size_t)64 * BM * D : base_lat) : X;
        f32x4 gv[2][2];
#pragma unroll
        for (int bj = 0; bj < 2; ++bj)
#pragma unroll
            for (int n = 0; n < 2; ++n) gv[bj][n] = *(const f32x4*)(gate + col0 + bj * HALF + n * 16);
#pragma unroll
        for (int ai = 0; ai < 2; ++ai)
#pragma unroll
            for (int m = 0; m < 4; ++m) { const size_t ro = (size_t)(row0 + ai * HALF + m * 16) * D + col0;
#pragma unroll
                for (int bj = 0; bj < 2; ++bj)
#pragma unroll
                    for (int n = 0; n < 2; ++n) *(f32x4*)(X + ro + bj * HALF + n * 16) = *(const f32x4*)(Bp + ro + bj * HALF + n * 16) + gv[bj][n] * acc[ai][bj][m][n]; }
    }
};
struct EpiSwiglu {
    static constexpr bool PERM = true, AFTER_DRAIN = false;
    bf16_t* O; int ldc, nN;
    __device__ __forceinline__ void operator()(const f32x4 (&acc)[2][2][4][2], const Unit& u, int wr, int wc, int fr, int fq) const {
        const int pnl = u.pn % nN;
        const int row0 = u.pm * BM + wr * 64 + fr, col0 = pnl * HALF + wc * 32 + 8 * fq;
#pragma unroll
        for (int ai = 0; ai < 2; ++ai)
#pragma unroll
            for (int m = 0; m < 4; ++m) { bf16_t* rowp = O + (size_t)(row0 + ai * HALF + m * 16) * ldc + col0;
                float h[8];
#pragma unroll
                for (int n = 0; n < 2; ++n)
#pragma unroll
                    for (int j = 0; j < 4; ++j) { const float g = acc[ai][0][m][n][j], up = acc[ai][1][m][n][j]; h[4 * n + j] = g * frcp(1.0f + fexp(-g)) * up; }
                u32x4 w; w.x = cvt_pk_bf16(h[0], h[1]); w.y = cvt_pk_bf16(h[2], h[3]); w.z = cvt_pk_bf16(h[4], h[5]); w.w = cvt_pk_bf16(h[6], h[7]);
                *(u32x4*)(rowp) = w; }
    }
};
struct EpiBf16N {
    static constexpr bool PERM = true, AFTER_DRAIN = false;
    bf16_t* O; int ldc, nN;
    __device__ __forceinline__ void operator()(const f32x4 (&acc)[2][2][4][2], const Unit& u, int wr, int wc, int fr, int fq) const {
        const int pnl = u.pn % nN;
        const int row0 = u.pm * BM + wr * 64 + fr, col0 = pnl * BM + wc * 32 + 8 * fq;
#pragma unroll
        for (int ai = 0; ai < 2; ++ai)
#pragma unroll
            for (int m = 0; m < 4; ++m) { bf16_t* rowp = O + (size_t)(row0 + ai * HALF + m * 16) * ldc + col0;
#pragma unroll
                for (int bj = 0; bj < 2; ++bj) { const f32x4 v0 = acc[ai][bj][m][0], v1 = acc[ai][bj][m][1];
                    u32x4 w; w.x = cvt_pk_bf16(v0[0], v0[1]); w.y = cvt_pk_bf16(v0[2], v0[3]); w.z = cvt_pk_bf16(v1[0], v1[1]); w.w = cvt_pk_bf16(v1[2], v1[3]);
                    *(u32x4*)(rowp + bj * HALF) = w; } }
    }
};


struct MoeSplitOrder {
    int nN, tile0, Mt, KS, Ksub, nwg, G, c; int tend[8];
    __device__ bool next(int i, Unit& u) const {
        const long L = (long)i * G + c; if (L >= nwg) return false;
        const int l = (int)L, ks = l % KS, r = l / KS, pnl = r % nN, pm = tile0 + r / nN;
        int e = 0;
#pragma unroll
        for (int j = 0; j < 7; ++j) e += (pm >= tend[j]) ? 1 : 0;
        u.pm = pm; u.pn = e * nN + pnl; u.ko = ks * Ksub; return true;
    }
    __device__ __forceinline__ void a_ready(const Unit&) const {}
    __device__ __forceinline__ void done(const Unit&) const {}
};
struct EpiF32Part {
    static constexpr bool PERM = false, AFTER_DRAIN = false;
    float* P; int row0, rows, ldc, nN, Ksub;
    __device__ __forceinline__ void operator()(const f32x4 (&acc)[2][2][4][2], const Unit& u, int wr, int wc, int fr, int fq) const {
        const int pnl = u.pn % nN, ks = u.ko / Ksub;
        const int r0 = u.pm * BM - row0 + wr * 64 + fr, col0 = pnl * BM + wc * 32 + 4 * fq;
        float* base = P + (size_t)ks * rows * ldc;
#pragma unroll
        for (int ai = 0; ai < 2; ++ai)
#pragma unroll
            for (int m = 0; m < 4; ++m) { float* rowp = base + (size_t)(r0 + ai * HALF + m * 16) * ldc + col0;
#pragma unroll
                for (int bj = 0; bj < 2; ++bj)
#pragma unroll
                    for (int n = 0; n < 2; ++n) *(f32x4*)(rowp + bj * HALF + n * 16) = acc[ai][bj][m][n]; }
    }
};

template <class Epi, class Sched, bool ALIGN_EPI = false, bool SP2 = false>
__device__ __forceinline__ void gemm_phase(PG8_LAS unsigned char* lds, const Gemm g, const Sched& S, const Epi& E) {
    const int tid = threadIdx.x, wid = __builtin_amdgcn_readfirstlane(tid >> 6), lane = tid & 63, wr = wid >> 2, wc = wid & 3, fr = lane & 15, fq = lane >> 4;
    const int K = g.K, nt = K / BK, LD = g.ld;
    unsigned voffA[2], voffB[2];
#pragma unroll
    for (int i = 0; i < 2; ++i) { int R, C; stage_rc(tid * 16 + i * 8192, R, C); const int Rb = Epi::PERM ? ((R & ~31) + perm32(R & 31)) : R;
        voffA[i] = (unsigned)(R * LD + C) * 2u; voffB[i] = (unsigned)(Rb * LD + C) * 2u; }
    const size_t kstep = (size_t)(BK * 2);
    const size_t hstep = (size_t)HALF * LD * 2;
    const size_t tstep = 2 * hstep;
    const unsigned ldsw = (unsigned)wid * 1024u;
    const int aoff = lds_byte(wr * 64 + fr, fq * 8), boff = lds_byte(wc * 32 + fr, fq * 8);
#define PG8_SA(b, h) (((b) * 2 + (h)) * HTB)
#define PG8_SB(b, h) ((4 + (b) * 2 + (h)) * HTB)
#define PG8_STAGE(bufoff, gbase, voff) do { _Pragma("unroll") for (int _i = 0; _i < 2; ++_i) \
        __builtin_amdgcn_global_load_lds((const unsigned*)((const char*)(gbase) + (voff)[_i]), (PG8_LAS unsigned*)(lds + (bufoff) + ldsw + _i * 8192), 16, 0, 0); } while (0)
#define PG8_LDA(dst, b, h) do { _Pragma("unroll") for (int m = 0; m < 4; ++m) _Pragma("unroll") for (int k = 0; k < 2; ++k) dst[m][k] = *(const PG8_LAS bf16x8*)(lds + PG8_SA(b, h) + aoff + m * 2048 + k * 1024); } while (0)
#define PG8_LDB(dst, b, h) do { _Pragma("unroll") for (int n = 0; n < 2; ++n) _Pragma("unroll") for (int k = 0; k < 2; ++k) dst[n][k] = *(const PG8_LAS bf16x8*)(lds + PG8_SB(b, h) + boff + n * 2048 + k * 1024); } while (0)
#define PG8_MMA(ai, bj, At, Bt) do { __builtin_amdgcn_s_setprio(1); _Pragma("unroll") for (int m = 0; m < 4; ++m) _Pragma("unroll") for (int n = 0; n < 2; ++n) _Pragma("unroll") for (int k = 0; k < 2; ++k) \
        acc[ai][bj][m][n] = __builtin_amdgcn_mfma_f32_16x16x32_bf16(Bt[n][k], At[m][k], acc[ai][bj][m][n], 0, 0, 0); __builtin_amdgcn_s_setprio(0); } while (0)
#define PG8_WAIT_V(n) asm volatile("s_waitcnt vmcnt(" #n ")" ::: "memory")
#define PG8_WAIT_L(n) asm volatile("s_waitcnt lgkmcnt(" #n ")" ::: "memory")
#define PG8_BAR __builtin_amdgcn_s_barrier()
#define PG8_SCHED __builtin_amdgcn_sched_barrier(0)
    Unit cur, nxt; int ui = 0;
    if (!S.next(0, cur)) return;
    f32x4 acc[2][2][4][2];
#pragma unroll
    for (int a = 0; a < 2; ++a)
#pragma unroll
        for (int b = 0; b < 2; ++b)
#pragma unroll
            for (int m = 0; m < 4; ++m)
#pragma unroll
                for (int n = 0; n < 2; ++n) acc[a][b][m][n] = (f32x4){0.f, 0.f, 0.f, 0.f};
    bf16x8 At[4][2], B0[2][2], B1[2][2];
    const char* cA = (const char*)g.A + (size_t)cur.pm * tstep + (size_t)cur.ko * 2; const char* cB = (const char*)g.Bt + (size_t)cur.pn * tstep + (size_t)cur.ko * 2;
    S.a_ready(cur);
    if constexpr (SP2) {
        PG8_STAGE(PG8_SB(0, 0), cB, voffB); PG8_STAGE(PG8_SB(0, 1), cB + hstep, voffB); PG8_STAGE(PG8_SA(0, 0), cA, voffA); PG8_STAGE(PG8_SA(0, 1), cA + hstep, voffA);
        if (wr == 1) PG8_BAR;
        PG8_WAIT_V(2); PG8_BAR;
        PG8_STAGE(PG8_SB(1, 0), cB + kstep, voffB); PG8_STAGE(PG8_SA(1, 0), cA + kstep, voffA); PG8_STAGE(PG8_SB(1, 1), cB + hstep + kstep, voffB);
        PG8_WAIT_V(6); PG8_BAR;
    } else {
        PG8_STAGE(PG8_SB(0, 0), cB, voffB); PG8_STAGE(PG8_SA(0, 0), cA, voffA); PG8_STAGE(PG8_SB(0, 1), cB + hstep, voffB); PG8_STAGE(PG8_SA(0, 1), cA + hstep, voffA);
        if (wr == 1) PG8_BAR;
        PG8_WAIT_V(4); PG8_BAR;
        PG8_STAGE(PG8_SB(1, 0), cB + kstep, voffB); PG8_STAGE(PG8_SA(1, 0), cA + kstep, voffA); PG8_STAGE(PG8_SB(1, 1), cB + hstep + kstep, voffB);
        PG8_WAIT_V(6); PG8_BAR;
    }
    for (;;) {
        const bool has_next = S.next(ui + 1, nxt);
        const char* nA = has_next ? (const char*)g.A + (size_t)nxt.pm * tstep + (size_t)nxt.ko * 2 : cA; const char* nB = has_next ? (const char*)g.Bt + (size_t)nxt.pn * tstep + (size_t)nxt.ko * 2 : cB;
        for (int t = 0; t < nt; t += 2) {
            const bool last = (t == nt - 2);
            const char* a1 = cA + (size_t)(t + 1) * kstep;
            const char* a2 = last ? nA : cA + (size_t)(t + 2) * kstep; const char* b2 = last ? nB : cB + (size_t)(t + 2) * kstep;
            const char* a3 = a2 + kstep; const char* b3 = b2 + kstep;
            if (last && has_next) S.a_ready(nxt);
            if constexpr (SP2) {
            PG8_LDB(B0, 0, 0); PG8_LDB(B1, 0, 1); PG8_SCHED; PG8_LDA(At, 0, 0); PG8_STAGE(PG8_SA(1, 1), a1 + hstep, voffA);
            PG8_WAIT_V(8); PG8_WAIT_L(0); PG8_BAR; PG8_MMA(0, 0, At, B0); PG8_MMA(0, 1, At, B1); PG8_BAR; PG8_SCHED;
            PG8_LDA(At, 0, 1); PG8_STAGE(PG8_SB(0, 0), b2, voffB); PG8_STAGE(PG8_SB(0, 1), b2 + hstep, voffB); PG8_STAGE(PG8_SA(0, 0), a2, voffA);
            PG8_WAIT_V(8); PG8_WAIT_L(0); PG8_BAR; PG8_MMA(1, 0, At, B0); PG8_MMA(1, 1, At, B1); PG8_BAR; PG8_SCHED;
            PG8_LDB(B0, 1, 0); PG8_LDB(B1, 1, 1); PG8_SCHED; PG8_LDA(At, 1, 0); PG8_STAGE(PG8_SA(0, 1), a2 + hstep, voffA);
            PG8_WAIT_V(8); PG8_WAIT_L(0); PG8_BAR; PG8_MMA(0, 0, At, B0); PG8_MMA(0, 1, At, B1); PG8_BAR; PG8_SCHED;
            PG8_LDA(At, 1, 1); PG8_STAGE(PG8_SB(1, 0), b3, voffB); PG8_STAGE(PG8_SB(1, 1), b3 + hstep, voffB); PG8_STAGE(PG8_SA(1, 0), a3, voffA);
            PG8_WAIT_V(8); PG8_WAIT_L(0); PG8_BAR; PG8_MMA(1, 0, At, B0); PG8_MMA(1, 1, At, B1); PG8_BAR; PG8_SCHED;
            } else {
            PG8_LDB(B0, 0, 0); PG8_SCHED; PG8_LDA(At, 0, 0); PG8_STAGE(PG8_SA(1, 1), a1 + hstep, voffA);
            PG8_WAIT_L(8); PG8_BAR; PG8_WAIT_L(0); PG8_MMA(0, 0, At, B0); PG8_BAR; PG8_SCHED;
            PG8_LDB(B1, 0, 1); PG8_STAGE(PG8_SB(0, 0), b2, voffB);
            PG8_BAR; PG8_WAIT_L(0); PG8_MMA(0, 1, At, B1); PG8_BAR;
            PG8_LDA(At, 0, 1); PG8_STAGE(PG8_SA(0, 0), a2, voffA);
            PG8_BAR; PG8_WAIT_L(0); PG8_MMA(1, 0, At, B0); PG8_BAR; PG8_SCHED;
            PG8_STAGE(PG8_SB(0, 1), b2 + hstep, voffB);
            PG8_WAIT_V(6); PG8_BAR; PG8_MMA(1, 1, At, B1); PG8_BAR;
            PG8_LDB(B0, 1, 0); PG8_SCHED; PG8_LDA(At, 1, 0); PG8_STAGE(PG8_SA(0, 1), a2 + hstep, voffA);
            PG8_WAIT_L(8); PG8_BAR; PG8_WAIT_L(0); PG8_MMA(0, 0, At, B0); PG8_BAR; PG8_SCHED;
            PG8_LDB(B1, 1, 1); PG8_STAGE(PG8_SB(1, 0), b3, voffB);
            PG8_BAR; PG8_WAIT_L(0); PG8_MMA(0, 1, At, B1); PG8_BAR;
            PG8_LDA(At, 1, 1); PG8_STAGE(PG8_SA(1, 0), a3, voffA);
            PG8_BAR; PG8_WAIT_L(0); PG8_MMA(1, 0, At, B0); PG8_BAR; PG8_SCHED;
            PG8_STAGE(PG8_SB(1, 1), b3 + hstep, voffB);
            PG8_WAIT_V(6); PG8_BAR; PG8_MMA(1, 1, At, B1); PG8_BAR;
            }
        }
        if constexpr (ALIGN_EPI) { if (wr == 0) PG8_BAR; }
        if constexpr (!Epi::AFTER_DRAIN) { E(acc, cur, wr, wc, fr, fq); S.done(cur); }
        if (!has_next) break;
#pragma unroll
        for (int a = 0; a < 2; ++a)
#pragma unroll
            for (int b = 0; b < 2; ++b)
#pragma unroll
                for (int m = 0; m < 4; ++m)
#pragma unroll
                    for (int n = 0; n < 2; ++n) acc[a][b][m][n] = (f32x4){0.f, 0.f, 0.f, 0.f};
        cur = nxt; cA = nA; cB = nB; ++ui;
        if constexpr (ALIGN_EPI) { if (wr == 1) PG8_BAR; }
    }
    PG8_WAIT_V(0);
    if constexpr (!ALIGN_EPI) { if (wr == 0) PG8_BAR; }
    PG8_BAR;
#undef PG8_SA
#undef PG8_SB
#undef PG8_STAGE
#undef PG8_LDA
#undef PG8_LDB
#undef PG8_MMA
#undef PG8_WAIT_V
#undef PG8_WAIT_L
#undef PG8_BAR
#undef PG8_SCHED
}

template <class Epi, class Sched>
__device__ __forceinline__ void gemm_phase_gather(PG8_LAS unsigned char* lds, const Gemm g, const int* rowmap, const Sched& S, const Epi& E) {
    const int tid = threadIdx.x, wid = __builtin_amdgcn_readfirstlane(tid >> 6), lane = tid & 63, wr = wid >> 2, wc = wid & 3, fr = lane & 15, fq = lane >> 4;
    const int K = g.K, nt = K / BK, LD = g.ld;
    unsigned voffB[2];
#pragma unroll
    for (int i = 0; i < 2; ++i) { int R, C; stage_rc(tid * 16 + i * 8192, R, C); const int Rb = Epi::PERM ? ((R & ~31) + perm32(R & 31)) : R;
        voffB[i] = (unsigned)(Rb * LD + C) * 2u; }
    const size_t kstep = (size_t)(BK * 2);
    const size_t hstep = (size_t)HALF * LD * 2;
    const size_t tstep = 2 * hstep;
    const unsigned ldsw = (unsigned)wid * 1024u;
    const int aoff = lds_byte(wr * 64 + fr, fq * 8), boff = lds_byte(wc * 32 + fr, fq * 8);
#define PG8_SA(b, h) (((b) * 2 + (h)) * HTB)
#define PG8_SB(b, h) ((4 + (b) * 2 + (h)) * HTB)
#define PG8_STAGE(bufoff, gbase, voff) do { _Pragma("unroll") for (int _i = 0; _i < 2; ++_i) \
        __builtin_amdgcn_global_load_lds((const unsigned*)((const char*)(gbase) + (voff)[_i]), (PG8_LAS unsigned*)(lds + (bufoff) + ldsw + _i * 8192), 16, 0, 0); } while (0)
#define PG8_LDA(dst, b, h) do { _Pragma("unroll") for (int m = 0; m < 4; ++m) _Pragma("unroll") for (int k = 0; k < 2; ++k) dst[m][k] = *(const PG8_LAS bf16x8*)(lds + PG8_SA(b, h) + aoff + m * 2048 + k * 1024); } while (0)
#define PG8_LDB(dst, b, h) do { _Pragma("unroll") for (int n = 0; n < 2; ++n) _Pragma("unroll") for (int k = 0; k < 2; ++k) dst[n][k] = *(const PG8_LAS bf16x8*)(lds + PG8_SB(b, h) + boff + n * 2048 + k * 1024); } while (0)
#define PG8_MMA(ai, bj, At, Bt) do { __builtin_amdgcn_s_setprio(1); _Pragma("unroll") for (int m = 0; m < 4; ++m) _Pragma("unroll") for (int n = 0; n < 2; ++n) _Pragma("unroll") for (int k = 0; k < 2; ++k) \
        acc[ai][bj][m][n] = __builtin_amdgcn_mfma_f32_16x16x32_bf16(Bt[n][k], At[m][k], acc[ai][bj][m][n], 0, 0, 0); __builtin_amdgcn_s_setprio(0); } while (0)
#define PG8_WAIT_V(n) asm volatile("s_waitcnt vmcnt(" #n ")" ::: "memory")
#define PG8_WAIT_L(n) asm volatile("s_waitcnt lgkmcnt(" #n ")" ::: "memory")
#define PG8_BAR __builtin_amdgcn_s_barrier()
#define PG8_SCHED __builtin_amdgcn_sched_barrier(0)
#define PG8_ROWOFFS(V, pm_) do { _Pragma("unroll") for (int i_ = 0; i_ < 2; ++i_) { int R_, C_; stage_rc(threadIdx.x * 16 + i_ * 8192, R_, C_); \
        _Pragma("unroll") for (int h_ = 0; h_ < 2; ++h_) V[h_][i_] = (unsigned)rowmap[(pm_) * BM + h_ * HALF + R_] * (unsigned)(LD * 2) + (unsigned)C_ * 2u; } } while (0)
    Unit cur, nxt; int ui = 0;
    if (!S.next(0, cur)) return;
    f32x4 acc[2][2][4][2];
#pragma unroll
    for (int a = 0; a < 2; ++a)
#pragma unroll
        for (int b = 0; b < 2; ++b)
#pragma unroll
            for (int m = 0; m < 4; ++m)
#pragma unroll
                for (int n = 0; n < 2; ++n) acc[a][b][m][n] = (f32x4){0.f, 0.f, 0.f, 0.f};
    bf16x8 At[4][2], B0[2][2], B1[2][2];
    const char* gA = (const char*)g.A; const char* cB = (const char*)g.Bt + (size_t)cur.pn * tstep;
    unsigned vA[2][2], vN[2][2];
    PG8_ROWOFFS(vA, cur.pm);
    PG8_STAGE(PG8_SB(0, 0), cB, voffB); PG8_STAGE(PG8_SB(0, 1), cB + hstep, voffB); PG8_STAGE(PG8_SA(0, 0), gA, vA[0]); PG8_STAGE(PG8_SA(0, 1), gA, vA[1]);
    if (wr == 1) PG8_BAR;
    PG8_WAIT_V(2); PG8_BAR;
    PG8_STAGE(PG8_SB(1, 0), cB + kstep, voffB); PG8_STAGE(PG8_SA(1, 0), gA + kstep, vA[0]); PG8_STAGE(PG8_SB(1, 1), cB + hstep + kstep, voffB);
    PG8_WAIT_V(6); PG8_BAR;
    for (;;) {
        const bool has_next = S.next(ui + 1, nxt);
        const char* nB = has_next ? (const char*)g.Bt + (size_t)nxt.pn * tstep : cB;
        if (has_next) PG8_ROWOFFS(vN, nxt.pm);
        else {
#pragma unroll
            for (int h_ = 0; h_ < 2; ++h_) { vN[h_][0] = vA[h_][0]; vN[h_][1] = vA[h_][1]; } }
        for (int t = 0; t < nt; t += 2) {
            const bool last = (t == nt - 2);
            const char* a1 = gA + (size_t)(t + 1) * kstep;
            const char* a2 = last ? gA : gA + (size_t)(t + 2) * kstep; const char* b2 = last ? nB : cB + (size_t)(t + 2) * kstep;
            const char* a3 = a2 + kstep; const char* b3 = b2 + kstep;
            unsigned v2[2][2];
#pragma unroll
            for (int h_ = 0; h_ < 2; ++h_) { v2[h_][0] = last ? vN[h_][0] : vA[h_][0]; v2[h_][1] = last ? vN[h_][1] : vA[h_][1]; }
            PG8_LDB(B0, 0, 0); PG8_LDB(B1, 0, 1); PG8_SCHED; PG8_LDA(At, 0, 0); PG8_STAGE(PG8_SA(1, 1), a1, vA[1]);
            PG8_WAIT_V(8); PG8_WAIT_L(0); PG8_BAR; PG8_MMA(0, 0, At, B0); PG8_MMA(0, 1, At, B1); PG8_BAR; PG8_SCHED;
            PG8_LDA(At, 0, 1); PG8_STAGE(PG8_SB(0, 0), b2, voffB); PG8_STAGE(PG8_SB(0, 1), b2 + hstep, voffB); PG8_STAGE(PG8_SA(0, 0), a2, v2[0]);
            PG8_WAIT_V(8); PG8_WAIT_L(0); PG8_BAR; PG8_MMA(1, 0, At, B0); PG8_MMA(1, 1, At, B1); PG8_BAR; PG8_SCHED;
            PG8_LDB(B0, 1, 0); PG8_LDB(B1, 1, 1); PG8_SCHED; PG8_LDA(At, 1, 0); PG8_STAGE(PG8_SA(0, 1), a2, v2[1]);
            PG8_WAIT_V(8); PG8_WAIT_L(0); PG8_BAR; PG8_MMA(0, 0, At, B0); PG8_MMA(0, 1, At, B1); PG8_BAR; PG8_SCHED;
            PG8_LDA(At, 1, 1); PG8_STAGE(PG8_SB(1, 0), b3, voffB); PG8_STAGE(PG8_SB(1, 1), b3 + hstep, voffB); PG8_STAGE(PG8_SA(1, 0), a3, v2[0]);
            PG8_WAIT_V(8); PG8_WAIT_L(0); PG8_BAR; PG8_MMA(1, 0, At, B0); PG8_MMA(1, 1, At, B1); PG8_BAR; PG8_SCHED;
        }
        if (wr == 0) PG8_BAR;
        E(acc, cur, wr, wc, fr, fq);
        if (!has_next) break;
#pragma unroll
        for (int a = 0; a < 2; ++a)
#pragma unroll
            for (int b = 0; b < 2; ++b)
#pragma unroll
                for (int m = 0; m < 4; ++m)
#pragma unroll
                    for (int n = 0; n < 2; ++n) acc[a][b][m][n] = (f32x4){0.f, 0.f, 0.f, 0.f};
        cur = nxt; cB = nB; ++ui;
#pragma unroll
        for (int h_ = 0; h_ < 2; ++h_) { vA[h_][0] = vN[h_][0]; vA[h_][1] = vN[h_][1]; }
        if (wr == 1) PG8_BAR;
    }
    PG8_WAIT_V(0);
    PG8_BAR;
#undef PG8_SA
#undef PG8_SB
#undef PG8_STAGE
#undef PG8_LDA
#undef PG8_LDB
#undef PG8_MMA
#undef PG8_WAIT_V
#undef PG8_WAIT_L
#undef PG8_BAR
#undef PG8_SCHED
#undef PG8_ROWOFFS
}
}

#define XB_TMO      128
#define XB_XCNT(j)  (256  + 64 * (j))
#define XB_XSUB(j)  (1280 + 64 * (j))
#define XB_XGEN(j)  (2304 + 64 * (j))
#define XB_TOP      3328
#define XB_TOPGEN   3392
#define XCD_BAR_WORDS 3456
#define XB_SPIN_CAP (1u << 21)
__device__ __forceinline__ unsigned xb_ld(unsigned* p)              { return __hip_atomic_load(p, __ATOMIC_RELAXED, __HIP_MEMORY_SCOPE_AGENT); }
__device__ __forceinline__ unsigned xb_add(unsigned* p, unsigned v) { return __hip_atomic_fetch_add(p, v, __ATOMIC_RELAXED, __HIP_MEMORY_SCOPE_AGENT); }
__device__ __forceinline__ unsigned xb_xcc_id() { return (unsigned)__builtin_amdgcn_s_getreg((3 << 11) | 20) & 0xFu; }
#define XB_SPIN(cond, bar) do { unsigned _sp = 0; while (cond) { __builtin_amdgcn_s_sleep(1); \
    if ((++_sp & 255u) == 0u) { if (xb_ld(&(bar)[XB_TMO])) break; if (_sp > XB_SPIN_CAP) { atomicAdd(&(bar)[XB_TMO], 1u); break; } } } } while (0)
struct XcdBarrier { unsigned* bar; unsigned x; volatile LAS unsigned* st; };
__device__ __forceinline__ XcdBarrier xcd_barrier_post(unsigned* bar, volatile LAS unsigned* st) {
    XcdBarrier b; b.bar = bar; b.x = xb_xcc_id(); b.st = st;
    if (threadIdx.x == 0) (void)xb_add(&bar[XB_XCNT(b.x)], 1u);
    return b;
}
__device__ __forceinline__ void xcd_barrier_complete(unsigned* bar, unsigned x, unsigned& nloc, unsigned& nx) {
    const unsigned G = gridDim.x * gridDim.y * gridDim.z;
    unsigned sum, cnt, mine, sp = 0u;
    for (;;) {
        sum = 0u; cnt = 0u; mine = 0u;
#pragma unroll
        for (unsigned j = 0; j < 16; ++j) { const unsigned c = xb_ld(&bar[XB_XCNT(j)]); sum += c; cnt += (c > 0u) ? 1u : 0u; mine = (j == x) ? c : mine; }
        if (sum == G) break;
        __builtin_amdgcn_s_sleep(1);
        if ((++sp & 255u) == 0u) { if (xb_ld(&bar[XB_TMO])) break; if (sp > XB_SPIN_CAP) { atomicAdd(&bar[XB_TMO], 1u); break; } }
    }
    nloc = mine > 0u ? mine : 1u; nx = cnt > 0u ? cnt : 1u;
}
__device__ __forceinline__ void xcd_barrier(const XcdBarrier& b) {
    asm volatile("s_waitcnt vmcnt(0)" ::: "memory");
    __syncthreads();
    if (threadIdx.x == 0) {
        unsigned* bar = b.bar;
        __builtin_amdgcn_s_waitcnt(0);
        unsigned nloc = b.st[0], nx = b.st[1];
        if (nloc == 0u) { xcd_barrier_complete(bar, b.x, nloc, nx); b.st[0] = nloc; b.st[1] = nx; }
        const unsigned old = xb_add(&bar[XB_XSUB(b.x)], 1u);
        const unsigned gen = old / nloc;
        if (old + 1u == (gen + 1u) * nloc) {
            __builtin_amdgcn_fence(__ATOMIC_RELEASE, "agent");
            asm volatile("s_waitcnt vmcnt(0)" ::: "memory");
            const unsigned og = xb_add(&bar[XB_TOP], 1u);
            const unsigned tg = og / nx;
            if (og + 1u == (tg + 1u) * nx) xb_add(&bar[XB_TOPGEN], 1u);
            else XB_SPIN(xb_ld(&bar[XB_TOPGEN]) == tg, bar);
            __builtin_amdgcn_fence(__ATOMIC_ACQUIRE, "agent");
            xb_add(&bar[XB_XGEN(b.x)], 1u);
            asm volatile("s_waitcnt vmcnt(0)" ::: "memory");
        } else {
            XB_SPIN(xb_ld(&bar[XB_XGEN(b.x)]) == gen, bar);
            __builtin_amdgcn_fence(__ATOMIC_ACQUIRE, "agent");
            asm volatile("s_waitcnt vmcnt(0)" ::: "memory");
        }
    }
    __syncthreads();
}

constexpr int NWAVES = 8, NTHREADS = 512;
constexpr int RING_BYTES = 155648;
constexpr int LDSCTL_OFF = RING_BYTES;
constexpr int LDS_BYTES = 163840;
enum { IN_X = 0, IN_C, IN_CTX, IN_CCTX, IN_MODW, IN_MODB, IN_N1G, IN_N2G, IN_EVWIN, IN_EVCONV, IN_ALOG, IN_DTB, IN_DNG, IN_LCW, IN_LCB, IN_LWA, IN_LBA, IN_LWX, IN_LBX, IN_LAM,
       IN_EVWOUT, IN_EVGATE, IN_EVUP, IN_EVDOWN, IN_ODWIN, IN_WG2, IN_BG, IN_GLAG, IN_ODWOUT, IN_RW, IN_RB, IN_XGATE, IN_XUP, IN_XDOWN, IN_FNG, N_IN };
struct Args { const float* in[N_IN]; float* out; unsigned char* ws; int ph_lo, ph_hi; };
constexpr int N_PHASES = 21;

__device__ __forceinline__ void p0_adaln(const Args& a, LAS unsigned char* lds, int tid, int layer, int wg, int nwg) {
    LAS float* s0 = (LAS float*)lds; LAS float* s1 = s0 + D; LAS float* red = s1 + D;
    for (int i = tid; i < D; i += NTHREADS) { s0[i] = siluf_(a.in[IN_C][i]); s1[i] = siluf_(a.in[IN_CCTX][i]); }
    __syncthreads();
    float* MOD = (float*)(a.ws + WS_MOD);
    const int cl = tid & 15, kg = tid >> 4;
    for (int cb = wg; cb < 192; cb += nwg) {
        const int col = cb * 64 + cl * 4;
        const float* W = a.in[IN_MODW] + (size_t)layer * D * (6 * D) + col;
        f32x4 a0 = {0.f, 0.f, 0.f, 0.f}, a1 = {0.f, 0.f, 0.f, 0.f};
#pragma unroll 8
        for (int kk = 0; kk < 64; ++kk) { const int k = kg * 64 + kk; const f32x4 w = *(const f32x4*)(W + (size_t)k * (6 * D)); a0 += w * s0[k]; a1 += w * s1[k]; }
        LAS float* r = red + (kg * 16 + cl) * 8;
        r[0] = a0[0]; r[1] = a0[1]; r[2] = a0[2]; r[3] = a0[3]; r[4] = a1[0]; r[5] = a1[1]; r[6] = a1[2]; r[7] = a1[3];
        __syncthreads();
        if (tid < 128) {
            const int cond = tid >> 6, c = tid & 63; float s = 0.f;
#pragma unroll
            for (int g = 0; g < 32; ++g) s += red[(g * 16 + (c >> 2)) * 8 + cond * 4 + (c & 3)];
            const int n = cb * 64 + c;
            MOD[((size_t)layer * 2 + cond) * (6 * D) + n] = s + a.in[IN_MODB][layer * 6 * D + n];
        }
        __syncthreads();
    }
}
template <int MAP> __device__ __forceinline__ int map_row(int n0) {
    if (MAP == 0) return n0;
    if (MAP == 1) return 256 * (n0 / 128) + (n0 % 128);
    if (MAP == 2) return 256 * (n0 / 128) + 128 + (n0 % 128);
    return n0 < 4096 ? n0 : (n0 < 4128 ? 6144 + (n0 - 4096) : n0 - 32);
}
template <int MAP> __device__ __forceinline__ void transpose_job(const float* W, int K, int N, bf16* WT, LAS float* scr, int gw, int ngw, int lane) {
    const int nblk = N / 32, nitems = (K / 64) * nblk;
    float cur[32], nxt[32];
#define TJ_LOAD(R, item_) do { const int kb_ = (item_) / nblk, nb_ = (item_) % nblk; const float* src_ = W + (size_t)(64 * kb_ + (lane >> 5)) * N + 32 * nb_ + (lane & 31); \
        _Pragma("unroll") for (int i = 0; i < 32; ++i) R[i] = src_[(size_t)(2 * i) * N]; } while (0)
    int item = gw;
    if (item < nitems) TJ_LOAD(cur, item);
    while (item < nitems) {
        const int nitem = item + ngw;
        if (nitem < nitems) TJ_LOAD(nxt, nitem);
        const int kb = item / nblk, nb = item % nblk, k0 = 64 * kb, n0 = 32 * nb;
#pragma unroll
        for (int i = 0; i < 32; ++i) scr[(2 * i + (lane >> 5)) * 33 + (lane & 31)] = cur[i];
        asm volatile("s_waitcnt lgkmcnt(0)" ::: "memory");
        const int c = lane & 7; const int r0 = map_row<MAP>(n0);
#pragma unroll
        for (int j = 0; j < 4; ++j) { const int n = (lane >> 3) + 8 * j; const LAS float* sp = scr + (8 * c) * 33 + n;
            u32x4 o; o.x = cvt_pk_bf16(sp[0 * 33], sp[1 * 33]); o.y = cvt_pk_bf16(sp[2 * 33], sp[3 * 33]); o.z = cvt_pk_bf16(sp[4 * 33], sp[5 * 33]); o.w = cvt_pk_bf16(sp[6 * 33], sp[7 * 33]);
            *(u32x4*)(WT + (size_t)(r0 + n) * K + k0 + 8 * c) = o; }
        asm volatile("s_waitcnt lgkmcnt(0)" ::: "memory");
#pragma unroll
        for (int i = 0; i < 32; ++i) cur[i] = nxt[i];
        item = nitem;
    }
#undef TJ_LOAD
}


constexpr int XITEMS_PER_JOB = 5632, XITEMS = 24 * XITEMS_PER_JOB;
__device__ __forceinline__ void expert_convert_range(const Args& a, LAS float* scr, int gi0, int gi1, int gw, int ngw, int lane) {
    float cur[32], nxt[32];
#define XJ_SETUP(gi_, W_, N_, nblk_, li_) const int job_##gi_ = (gi_) / XITEMS_PER_JOB, li_ = (gi_) % XITEMS_PER_JOB, e_##gi_ = job_##gi_ / 3, mat_##gi_ = job_##gi_ % 3; \
        const int N_ = mat_##gi_ == 2 ? D : FF, nblk_ = N_ / 32; \
        const float* W_ = (mat_##gi_ == 0 ? a.in[IN_XGATE] : (mat_##gi_ == 1 ? a.in[IN_XUP] : a.in[IN_XDOWN])) + (size_t)e_##gi_ * D * FF;
#define XJ_LOAD(R, W_, N_, nblk_, li_) do { const int kb_ = (li_) / (nblk_), nb_ = (li_) % (nblk_); const float* src_ = (W_) + (size_t)(64 * kb_ + (lane >> 5)) * (N_) + 32 * nb_ + (lane & 31); \
        _Pragma("unroll") for (int i = 0; i < 32; ++i) R[i] = __builtin_nontemporal_load(src_ + (size_t)(2 * i) * (N_)); } while (0)
    int gi = gi0 + gw;
    if (gi < gi1) { XJ_SETUP(gi, W0, N0, nb0, li0) XJ_LOAD(cur, W0, N0, nb0, li0); }
    while (gi < gi1) {
        const int gn = gi + ngw;
        if (gn < gi1) { XJ_SETUP(gn, W1, N1, nb1, li1) XJ_LOAD(nxt, W1, N1, nb1, li1); }
        const int job = gi / XITEMS_PER_JOB, li = gi % XITEMS_PER_JOB, e = job / 3, mat = job % 3;
        const int N = mat == 2 ? D : FF, K = mat == 2 ? FF : D, nblk = N / 32, kb = li / nblk, nb = li % nblk, k0 = 64 * kb, n0 = 32 * nb;
        bf16* WT = mat == 2 ? (bf16*)(a.ws + WS_W_XDN) + (size_t)e * D * FF : (bf16*)(a.ws + WS_W_XGU) + (size_t)e * 2 * FF * D;
        const int r0 = mat == 2 ? n0 : 256 * (n0 / 128) + (n0 % 128) + (mat == 1 ? 128 : 0);
#pragma unroll
        for (int i = 0; i < 32; ++i) scr[(2 * i + (lane >> 5)) * 33 + (lane & 31)] = cur[i];
        asm volatile("s_waitcnt lgkmcnt(0)" ::: "memory");
        const int c = lane & 7;
#pragma unroll
        for (int j = 0; j < 4; ++j) { const int n = (lane >> 3) + 8 * j; const LAS float* sp = scr + (8 * c) * 33 + n;
            u32x4 o; o.x = cvt_pk_bf16(sp[0 * 33], sp[1 * 33]); o.y = cvt_pk_bf16(sp[2 * 33], sp[3 * 33]); o.z = cvt_pk_bf16(sp[4 * 33], sp[5 * 33]); o.w = cvt_pk_bf16(sp[6 * 33], sp[7 * 33]);
            *(u32x4*)(WT + (size_t)(r0 + n) * K + k0 + 8 * c) = o; }
        asm volatile("s_waitcnt lgkmcnt(0)" ::: "memory");
#pragma unroll
        for (int i = 0; i < 32; ++i) cur[i] = nxt[i];
        gi = gn;
    }
#undef XJ_SETUP
#undef XJ_LOAD
}
constexpr int XC_GW2 = 233, XC_GW7 = 176, XC_GW9 = 240, XC_GW10 = 176;
constexpr int XC_B0 = 0, XC_B1 = 15000, XC_B2 = 39000, XC_B3 = 54000, XC_B4 = 120000, XC_B5 = XITEMS;
constexpr int XC_GW12 = 233;

__device__ __forceinline__ void norm_row(const float* src, const float* g, const float* sh, const float* sc, bf16* dst, float* copy_dst, int lane, f32x4 (&h)[8]) {
    f32x4 v[8]; float ss = 0.f;
#pragma unroll
    for (int j = 0; j < 8; ++j) { v[j] = *(const f32x4*)(src + 4 * lane + 256 * j); ss += (v[j][0] * v[j][0] + v[j][1] * v[j][1]) + (v[j][2] * v[j][2] + v[j][3] * v[j][3]); }
    if (copy_dst) {
#pragma unroll
        for (int j = 0; j < 8; ++j) *(f32x4*)(copy_dst + 4 * lane + 256 * j) = v[j];
    }
    const float rstd = 1.0f / sqrtf(wave_sum(ss) * (1.0f / D) + EPS);
#pragma unroll
    for (int j = 0; j < 8; ++j) { const int c = 4 * lane + 256 * j; const f32x4 gg = *(const f32x4*)(g + c), s1 = *(const f32x4*)(sc + c), s0 = *(const f32x4*)(sh + c);
        h[j] = (v[j] * rstd * gg) * (1.0f + s1) + s0;
        u32x2 w; w.x = cvt_pk_bf16(h[j][0], h[j][1]); w.y = cvt_pk_bf16(h[j][2], h[j][3]); *(u32x2*)(dst + c) = w; }
}

__device__ __forceinline__ void norm_stage_ab(LAS float* A, LAS float* B, const float* g, const float* sh, const float* sc, int tid) {
    for (int i = tid; i < D; i += NTHREADS) { A[i] = g[i] * (1.0f + sc[i]); B[i] = sh[i]; }
}
__device__ __forceinline__ void norm_row_ab(const float* src, const LAS float* A, const LAS float* B, bf16* dst, int lane, f32x4 (&h)[8]) {
    f32x4 v[8]; float ss = 0.f;
#pragma unroll
    for (int j = 0; j < 8; ++j) { v[j] = *(const f32x4*)(src + 4 * lane + 256 * j); ss += (v[j][0] * v[j][0] + v[j][1] * v[j][1]) + (v[j][2] * v[j][2] + v[j][3] * v[j][3]); }
    const float rstd = 1.0f / sqrtf(wave_sum(ss) * (1.0f / D) + EPS);
#pragma unroll
    for (int j = 0; j < 8; ++j) { const int c = 4 * lane + 256 * j;
        h[j] = (v[j] * rstd) * *(const LAS f32x4*)(A + c) + *(const LAS f32x4*)(B + c);
        u32x2 w; w.x = cvt_pk_bf16(h[j][0], h[j][1]); w.y = cvt_pk_bf16(h[j][2], h[j][3]); *(u32x2*)(dst + c) = w; }
}
__device__ __forceinline__ void ev_prep_load(const Args& a, int r, int qt, int lane, u32x4 (&x)[2][4]) {
    const bf16* PROJ = (const bf16*)(a.ws + WS_PROJ); const int lo = r < T ? 0 : T, hi = r < T ? T : MT;
#pragma unroll
    for (int t = 0; t < 2; ++t) { const int col = qt < 3 ? ((2 * qt + t) * 64 + lane) * 8 : 4096 + (t * 64 + lane) * 8;
#pragma unroll
        for (int jj = 0; jj < 4; ++jj) { const int rr = r + jj - 2; x[t][jj] = (rr >= lo && rr < hi) ? *(const u32x4*)(PROJ + (size_t)rr * NPROJ + col) : (u32x4){0u, 0u, 0u, 0u}; } }
}
__device__ __forceinline__ void ev_prep_compute(const Args& a, int r, int qt, int lane, const u32x4 (&x)[2][4], const LAS float* cwq, const LAS float* cwl, const LAS float* cbl) {
    bf16* QN = (bf16*)(a.ws + WS_QN); bf16* KN = (bf16*)(a.ws + WS_KN); bf16* VC = (bf16*)(a.ws + WS_VC); bf16* XC = (bf16*)(a.ws + WS_XC);
    asm volatile("" ::: "memory");
    const bool lru = (qt == 3);
#pragma unroll
    for (int t = 0; t < 2; ++t) {
        const int ch0 = lru ? (t * 64 + lane) * 8 : ((2 * qt + t) * 64 + lane) * 8;
        const LAS float* cw = lru ? cwl : cwq; const int cstride = lru ? 1024 : 3072;
        float acc[8];
        if (lru) { const f32x4 b0 = *(const LAS f32x4*)(cbl + ch0), b1 = *(const LAS f32x4*)(cbl + ch0 + 4);
#pragma unroll
            for (int e = 0; e < 4; ++e) { acc[e] = b0[e]; acc[4 + e] = b1[e]; } }
        else {
#pragma unroll
            for (int e = 0; e < 8; ++e) acc[e] = 0.f; }
#pragma unroll
        for (int jj = 0; jj < 4; ++jj) { float xv[8]; unpack8(x[t][jj], xv);
            const f32x4 w0 = *(const LAS f32x4*)(cw + jj * cstride + ch0), w1 = *(const LAS f32x4*)(cw + jj * cstride + ch0 + 4);
#pragma unroll
            for (int e = 0; e < 4; ++e) { acc[e] += xv[e] * w0[e]; acc[4 + e] += xv[4 + e] * w1[e]; } }
        if (lru) { *(u32x4*)(XC + (size_t)r * 1024 + ch0) = pack8(acc); }
        else {
            float ss = 0.f;
#pragma unroll
            for (int e = 0; e < 8; ++e) { acc[e] = siluf_(acc[e]); ss += acc[e] * acc[e]; }
            if (qt < 2) { ss = sum16(ss); const float sc = (1.0f / sqrtf(ss + EPS)) * (qt == 0 ? 0.08838834764831845f : 1.0f);
#pragma unroll
                for (int e = 0; e < 8; ++e) acc[e] *= sc; }
            bf16* dst = (qt == 0 ? QN : (qt == 1 ? KN : VC)) + (size_t)r * 1024 + (ch0 - 1024 * qt);
            *(u32x4*)dst = pack8(acc);
        }
    }
    if (qt == 3 && lane < 16) {
        const float* AUX = (const float*)(a.ws + WS_AUX); float* G = (float*)(a.ws + WS_GB); float* BETA = G + 16 * MT;
        const float araw = AUX[(size_t)r * 32 + lane], braw = AUX[(size_t)r * 32 + 16 + lane];
        G[(size_t)lane * MT + r] = -fexp(a.in[IN_ALOG][lane]) * softplusf_(araw + a.in[IN_DTB][lane]);
        BETA[(size_t)lane * MT + r] = sigmoidf_(braw);
    }
}

constexpr int NCH = MT / 64;
__device__ __forceinline__ int scan_row(int step, int d) { return step < CT ? T + (d ? CT - 1 - step : step) : (d ? T - 1 - (step - CT) : (step - CT)); }


#define LDS_BARRIER() do { asm volatile("s_waitcnt lgkmcnt(0)" ::: "memory"); __builtin_amdgcn_s_barrier(); asm volatile("" ::: "memory"); } while (0)
constexpr int DNB_W = 0, DNB_KT = 16384, DNB_QK = 32768, DNB_U = 40960, DNB_EG = 57344, DNB_GL = 57600, DNB_STRIDE = 57856;
constexpr int DN_WAVE_LDS = 16384 + 512;
__device__ __forceinline__ bf16x8 mk8(unsigned a, unsigned b, unsigned c, unsigned d) { u32x4 v = {a, b, c, d}; return __builtin_bit_cast(bf16x8, v); }
__device__ __forceinline__ f32x4 mfma16(bf16x8 a, bf16x8 b, f32x4 c) { return __builtin_amdgcn_mfma_f32_16x16x32_bf16(a, b, c, 0, 0, 0); }
__device__ __forceinline__ u32x2 pack4(const f32x4 v) { u32x2 w; w.x = cvt_pk_bf16(v[0], v[1]); w.y = cvt_pk_bf16(v[2], v[3]); return w; }
__device__ __forceinline__ bf16x8 pack_pair(const f32x4 lo, const f32x4 hi) { return mk8(cvt_pk_bf16(lo[0], lo[1]), cvt_pk_bf16(lo[2], lo[3]), cvt_pk_bf16(hi[0], hi[1]), cvt_pk_bf16(hi[2], hi[3])); }

__device__ __forceinline__ void dn_prep_unit(const Args& a, LAS unsigned char* wl, int unit, int lane) {
    const int c = unit % NCH, hd = unit / NCH, h = hd & 7, d = hd >> 3;
    const int m = lane & 15, q = lane >> 4;
    const bf16* QN = (const bf16*)(a.ws + WS_QN); const bf16* KN = (const bf16*)(a.ws + WS_KN); const bf16* VC = (const bf16*)(a.ws + WS_VC);
    const float* G = (const float*)(a.ws + WS_GB); const float* BETA = G + 16 * MT;
    unsigned char* blob = a.ws + WS_DNB + (size_t)unit * DNB_STRIDE;
    LAS float* Al = (LAS float*)wl; LAS float* gcs = (LAS float*)(wl + 16384); LAS float* bts = gcs + 64;
    size_t rowoff[4];
#pragma unroll
    for (int mt = 0; mt < 4; ++mt) rowoff[mt] = (size_t)scan_row(64 * c + 16 * mt + m, d) * 1024 + h * 128 + 8 * q;
    bf16x8 KA[4][4];
#pragma unroll
    for (int mt = 0; mt < 4; ++mt)
#pragma unroll
        for (int kb = 0; kb < 4; ++kb) KA[mt][kb] = *(const bf16x8*)(KN + rowoff[mt] + 32 * kb);
    const int rl = scan_row(64 * c + lane, d);
    float gc = G[(size_t)(d * 8 + h) * MT + rl]; const float bp = BETA[(size_t)(d * 8 + h) * MT + rl];
#pragma unroll
    for (int o = 1; o < 64; o <<= 1) { const float t = __shfl_up(gc, o); if (lane >= o) gc += t; }
    const float gl = __shfl(gc, 63);
    gcs[lane] = gc; bts[lane] = bp;
    ((float*)(blob + DNB_EG))[lane] = fexp(gc);
    if (lane == 0) *(float*)(blob + DNB_GL) = fexp(gl);
    f32x4 gci[4], bti[4]; float gcm[4];
#pragma unroll
    for (int mt = 0; mt < 4; ++mt) { gci[mt] = *(const LAS f32x4*)(gcs + 16 * mt + 4 * q); bti[mt] = *(const LAS f32x4*)(bts + 16 * mt + 4 * q); gcm[mt] = gcs[16 * mt + m]; }
    {
#pragma unroll
    for (int mt = 0; mt < 4; ++mt)
#pragma unroll
        for (int nt = 0; nt < 4; ++nt) if (nt <= mt) {
            f32x4 acc = {0.f, 0.f, 0.f, 0.f};
#pragma unroll
            for (int kb = 0; kb < 4; ++kb) acc = mfma16(KA[mt][kb], KA[nt][kb], acc);
#pragma unroll
            for (int e = 0; e < 4; ++e) { const int i = 16 * mt + 4 * q + e, j = 16 * nt + m; Al[i * 64 + j] = (j < i) ? acc[e] * bti[mt][e] * fexp(gci[mt][e] - gcm[nt]) : 0.f; }
        } else {
#pragma unroll
            for (int e = 0; e < 4; ++e) Al[(16 * mt + 4 * q + e) * 64 + 16 * nt + m] = 0.f;
        }
    {
#pragma unroll
        for (int mt = 0; mt < 4; ++mt) {
            bf16x8 QAm[4];
#pragma unroll
            for (int kb = 0; kb < 4; ++kb) QAm[kb] = *(const bf16x8*)(QN + rowoff[mt] + 32 * kb);
#pragma unroll
            for (int t = 0; t < 4; ++t) {
                f32x4 acc = {0.f, 0.f, 0.f, 0.f};
                if (t <= mt) {
#pragma unroll
                    for (int kb = 0; kb < 4; ++kb) acc = mfma16(KA[t][kb], QAm[kb], acc);
#pragma unroll
                    for (int e = 0; e < 4; ++e) { const int j = 16 * t + 4 * q + e, i = 16 * mt + m; acc[e] = (j <= i) ? acc[e] * fexp(gcm[mt] - gci[t][e]) : 0.f; }
                }
                *(u32x2*)(blob + DNB_QK + ((mt * 2 + (t >> 1)) * 64 + lane) * 16 + (t & 1) * 8) = pack4(acc);
            }
        }
    }
    }
    for (int b = 0; b < 4; ++b) {
        float acc[16];
#pragma unroll
        for (int r = 0; r < 16; ++r) acc[r] = (lane == 16 * b + r) ? 1.f : 0.f;
        for (int jb = 0; jb < b; ++jb) {
            float tj[16];
#pragma unroll
            for (int j = 0; j < 16; ++j) tj[j] = Al[(16 * jb + j) * 64 + lane];
#pragma unroll
            for (int r = 0; r < 16; ++r) {
#pragma unroll
                for (int j4 = 0; j4 < 4; ++j4) { const f32x4 av = *(const LAS f32x4*)(Al + (16 * b + r) * 64 + 16 * jb + 4 * j4);
                    acc[r] -= av[0] * tj[4 * j4] + av[1] * tj[4 * j4 + 1] + av[2] * tj[4 * j4 + 2] + av[3] * tj[4 * j4 + 3]; } }
        }
#pragma unroll
        for (int r = 1; r < 16; ++r) {
#pragma unroll
            for (int j4 = 0; j4 < (r + 3) / 4; ++j4) { const f32x4 av = *(const LAS f32x4*)(Al + (16 * b + r) * 64 + 16 * b + 4 * j4);
#pragma unroll
                for (int e = 0; e < 4; ++e) if (4 * j4 + e < r) acc[r] -= av[e] * acc[4 * j4 + e]; } }
#pragma unroll
        for (int r = 0; r < 16; ++r) Al[(16 * b + r) * 64 + lane] = acc[r];
    }
    bf16x8 TA[4][2];
#pragma unroll
    for (int mt = 0; mt < 4; ++mt)
#pragma unroll
        for (int kb = 0; kb < 2; ++kb) { const f32x4 p0 = *(const LAS f32x4*)(Al + (16 * mt + m) * 64 + 32 * kb + 4 * q), p1 = *(const LAS f32x4*)(Al + (16 * mt + m) * 64 + 32 * kb + 16 + 4 * q);
            TA[mt][kb] = pack_pair(p0, p1);
            }
    bf16x8 id0, id1;
#pragma unroll
    for (int jj = 0; jj < 8; ++jj) { id0[jj] = (8 * q + jj == m) ? (short)0x3F80 : (short)0; id1[jj] = (8 * q + jj == 16 + m) ? (short)0x3F80 : (short)0; }
    {
        asm volatile("" ::: "memory");
        bf16x8 KB[4][4];
#pragma unroll
        for (int mt = 0; mt < 4; ++mt)
#pragma unroll
            for (int kb = 0; kb < 4; ++kb) KB[mt][kb] = *(const bf16x8*)(KN + rowoff[mt] + 32 * kb);
        f32x4 sA[4], sK[4];
#pragma unroll
        for (int jt = 0; jt < 4; ++jt)
#pragma unroll
            for (int e = 0; e < 4; ++e) { sA[jt][e] = bti[jt][e] * fexp(gci[jt][e]); sK[jt][e] = fexp(gl - gci[jt][e]); }
#pragma unroll
        for (int dt = 0; dt < 8; ++dt) {
            f32x4 Kc[4];
#pragma unroll
            for (int jt = 0; jt < 4; ++jt) { Kc[jt] = mfma16(KB[jt][dt >> 1], (dt & 1) ? id1 : id0, (f32x4){0.f, 0.f, 0.f, 0.f});
                *(u32x2*)(blob + DNB_KT + ((dt * 2 + (jt >> 1)) * 64 + lane) * 16 + (jt & 1) * 8) = pack4(Kc[jt] * sK[jt]); }
            bf16x8 Aop[2];
#pragma unroll
            for (int kb = 0; kb < 2; ++kb) Aop[kb] = pack_pair(Kc[2 * kb] * sA[2 * kb], Kc[2 * kb + 1] * sA[2 * kb + 1]);
#pragma unroll
            for (int it = 0; it < 4; ++it) { f32x4 acc = {0.f, 0.f, 0.f, 0.f};
#pragma unroll
                for (int kb = 0; kb < 2; ++kb) acc = mfma16(Aop[kb], TA[it][kb], acc);
                *(u32x2*)(blob + DNB_W + ((it * 4 + (dt >> 1)) * 64 + lane) * 16 + (dt & 1) * 8) = pack4(acc); }
        }
    }
    {
        bf16x8 VA[4][4];
#pragma unroll
        for (int mt = 0; mt < 4; ++mt)
#pragma unroll
            for (int kb = 0; kb < 4; ++kb) VA[mt][kb] = *(const bf16x8*)(VC + rowoff[mt] + 32 * kb);
#pragma unroll
        for (int nt = 0; nt < 8; ++nt) {
            f32x4 Vc[4];
#pragma unroll
            for (int jt = 0; jt < 4; ++jt) Vc[jt] = mfma16(VA[jt][nt >> 1], (nt & 1) ? id1 : id0, (f32x4){0.f, 0.f, 0.f, 0.f}) * bti[jt];
            bf16x8 Vop[2];
#pragma unroll
            for (int kb = 0; kb < 2; ++kb) Vop[kb] = pack_pair(Vc[2 * kb], Vc[2 * kb + 1]);
#pragma unroll
            for (int mt = 0; mt < 4; ++mt) { f32x4 acc = {0.f, 0.f, 0.f, 0.f};
#pragma unroll
                for (int kb = 0; kb < 2; ++kb) acc = mfma16(TA[mt][kb], Vop[kb], acc);
                *(u32x2*)(blob + DNB_U + ((mt * 8 + nt) * 64 + lane) * 8) = pack4(acc); }
        }
    }
}

constexpr int DS_STAGE = 32768 + 256, DS_SX = 2 * DS_STAGE, DS_VX = DS_SX + 8192;
__device__ __forceinline__ unsigned char* dn_snap_base(const Args& a, int d, int h) { return a.ws + (d ? WS_KN : WS_H) + (size_t)(h * NCH) * 32768; }
__device__ __forceinline__ void dn_scan2(const Args& a, LAS unsigned char* lds, int tid, int h, int d, int sl) {
    const int lane = tid & 63, w = __builtin_amdgcn_readfirstlane(tid >> 6);
    unsigned char* blob0 = a.ws + WS_DNB + (size_t)((d * 8 + h) * NCH) * DNB_STRIDE;
    unsigned char* snap0 = dn_snap_base(a, d, h) + sl * 8192;
    if (w >= 4) {
        const int lt = tid - 256;
        u32x4 r0[8], r1[8], r2[8], r3[8]; float g0 = 0.f, g1 = 0.f, g2 = 0.f, g3 = 0.f;
#define DS_LOADSET(R, gx, s_) do { if ((s_) < NCH) { const unsigned char* bl_ = blob0 + (size_t)(s_) * DNB_STRIDE; \
            _Pragma("unroll") for (int i = 0; i < 8; ++i) R[i] = *(const u32x4*)(bl_ + (lt + 256 * i) * 16); \
            if (lt == 0) gx = *(const float*)(bl_ + DNB_GL); } } while (0)
#define DS_STORESET(R, gx, s_) do { if ((s_) < NCH) { LAS unsigned char* buf_ = lds + ((s_) & 1) * DS_STAGE; \
            _Pragma("unroll") for (int i = 0; i < 8; ++i) *(LAS u32x4*)(buf_ + (lt + 256 * i) * 16) = R[i]; \
            if (lt == 0) *(LAS float*)(buf_ + 32768) = gx; } } while (0)
#define DS_COPY_VN(s_) do { _Pragma("unroll") for (int i = 0; i < 2; ++i) { const int p_ = lt + 256 * i, f_ = p_ >> 7, l_ = (p_ >> 1) & 63, pc_ = p_ & 1; \
            *(u32x2*)(blob0 + (size_t)(s_) * DNB_STRIDE + DNB_U + (((2 * (f_ >> 1) + pc_) * 8 + 2 * sl + (f_ & 1)) * 64 + l_) * 8) = *(const LAS u32x2*)(lds + DS_VX + p_ * 8); } } while (0)
#define DS_COPY_SX(s_) do { _Pragma("unroll") for (int i = 0; i < 2; ++i) *(u32x4*)(snap0 + (size_t)(s_) * 32768 + (lt + 256 * i) * 16) = *(const LAS u32x4*)(lds + DS_SX + (lt + 256 * i) * 16); } while (0)
#define DS_STEP(RL, gl_, RS, gs_, s_) do { if ((s_) > 0) DS_COPY_VN((s_) - 1); DS_LOADSET(RL, gl_, (s_) + 4); LDS_BARRIER(); DS_STORESET(RS, gs_, (s_) + 1); DS_COPY_SX(s_); LDS_BARRIER(); } while (0)
        DS_LOADSET(r0, g0, 0); DS_LOADSET(r1, g1, 1); DS_LOADSET(r2, g2, 2); DS_LOADSET(r3, g3, 3); DS_STORESET(r0, g0, 0);
        LDS_BARRIER();
        for (int s = 0; s < NCH; s += 4) {
            DS_STEP(r0, g0, r1, g1, s); DS_STEP(r1, g1, r2, g2, s + 1); DS_STEP(r2, g2, r3, g3, s + 2); DS_STEP(r3, g3, r0, g0, s + 3);
        }
        DS_COPY_VN(NCH - 1);
#undef DS_LOADSET
#undef DS_STORESET
#undef DS_COPY_VN
#undef DS_COPY_SX
#undef DS_STEP
        return;
    }
    f32x4 S[2][2];
#pragma unroll
    for (int i = 0; i < 2; ++i) { S[i][0] = (f32x4){0.f, 0.f, 0.f, 0.f}; S[i][1] = (f32x4){0.f, 0.f, 0.f, 0.f}; }
    u32x2 ua[2], ub[2];
#define DS_ULOAD(U, s_) do { if ((s_) < NCH) { _Pragma("unroll") for (int nl = 0; nl < 2; ++nl) U[nl] = *(const u32x2*)(blob0 + (size_t)(s_) * DNB_STRIDE + DNB_U + ((w * 8 + 2 * sl + nl) * 64 + lane) * 8); } } while (0)
#define DS_CSTEP(U, s_) do { const LAS unsigned char* buf = lds + ((s_) & 1) * DS_STAGE; \
        _Pragma("unroll") for (int nl = 0; nl < 2; ++nl) *(LAS bf16x8*)(lds + DS_SX + ((w * 2 + nl) * 64 + lane) * 16) = pack_pair(S[0][nl], S[1][nl]); \
        LDS_BARRIER(); \
        f32x4 acc[2] = {(f32x4){0.f, 0.f, 0.f, 0.f}, (f32x4){0.f, 0.f, 0.f, 0.f}}; \
        _Pragma("unroll") for (int kb = 0; kb < 4; ++kb) { const bf16x8 af = *(const LAS bf16x8*)(buf + ((w * 4 + kb) * 64 + lane) * 16); \
            _Pragma("unroll") for (int nl = 0; nl < 2; ++nl) acc[nl] = mfma16(af, *(const LAS bf16x8*)(lds + DS_SX + ((kb * 2 + nl) * 64 + lane) * 16), acc[nl]); } \
        _Pragma("unroll") for (int nl = 0; nl < 2; ++nl) { const f32x4 uu = {bf2f(U[nl].x & 0xffffu), bf2f(U[nl].x >> 16), bf2f(U[nl].y & 0xffffu), bf2f(U[nl].y >> 16)}; \
            *(LAS u32x2*)(lds + DS_VX + (((w >> 1) * 2 + nl) * 64 + lane) * 16 + (w & 1) * 8) = pack4(uu - acc[nl]); } \
        DS_ULOAD(U, (s_) + 2); \
        LDS_BARRIER(); \
        const float glv = *(const LAS float*)(buf + 32768); \
        _Pragma("unroll") for (int i = 0; i < 2; ++i) _Pragma("unroll") for (int nl = 0; nl < 2; ++nl) { f32x4 ac = S[i][nl] * glv; \
            _Pragma("unroll") for (int kb = 0; kb < 2; ++kb) ac = mfma16(*(const LAS bf16x8*)(buf + 16384 + (((2 * w + i) * 2 + kb) * 64 + lane) * 16), *(const LAS bf16x8*)(lds + DS_VX + ((kb * 2 + nl) * 64 + lane) * 16), ac); \
            S[i][nl] = ac; } } while (0)
    DS_ULOAD(ua, 0); DS_ULOAD(ub, 1);
    LDS_BARRIER();
    for (int s = 0; s < NCH; s += 2) { DS_CSTEP(ua, s); DS_CSTEP(ub, s + 1); }
#undef DS_ULOAD
#undef DS_CSTEP
}
__device__ __forceinline__ void dn_out_unit(const Args& a, int unit, int lane) {
    const int c = unit % NCH, hd = unit / NCH, h = hd & 7, d = hd >> 3, m = lane & 15, q = lane >> 4;
    const bf16* QN = (const bf16*)(a.ws + WS_QN); bf16* ODN = (bf16*)(a.ws + WS_ODN);
    const unsigned char* blob = a.ws + WS_DNB + (size_t)unit * DNB_STRIDE;
    const unsigned char* snap = dn_snap_base(a, d, h) + (size_t)c * 32768;
    bf16x8 QF[4][4], QKF[4][2]; f32x4 eg[4]; size_t orow[4][4];
#pragma unroll
    for (int mt = 0; mt < 4; ++mt) { const bf16* qr = QN + (size_t)scan_row(64 * c + 16 * mt + m, d) * 1024 + h * 128 + 4 * q;
#pragma unroll
        for (int kb = 0; kb < 4; ++kb) { const u32x2 p0 = *(const u32x2*)(qr + 32 * kb), p1 = *(const u32x2*)(qr + 32 * kb + 16); QF[mt][kb] = mk8(p0.x, p0.y, p1.x, p1.y); }
#pragma unroll
        for (int kb = 0; kb < 2; ++kb) QKF[mt][kb] = *(const bf16x8*)(blob + DNB_QK + ((mt * 2 + kb) * 64 + lane) * 16);
        eg[mt] = *(const f32x4*)(blob + DNB_EG + (16 * mt + 4 * q) * 4);
#pragma unroll
        for (int e = 0; e < 4; ++e) orow[mt][e] = ((size_t)d * MT + scan_row(64 * c + 16 * mt + 4 * q + e, d)) * 1024 + h * 128 + m; }
#pragma unroll
    for (int nt = 0; nt < 8; ++nt) {
        bf16x8 Sf[4], Vf[2];
#pragma unroll
        for (int kb = 0; kb < 4; ++kb) Sf[kb] = *(const bf16x8*)(snap + (nt >> 1) * 8192 + ((kb * 2 + (nt & 1)) * 64 + lane) * 16);
#pragma unroll
        for (int kb = 0; kb < 2; ++kb) { const u32x2 p0 = *(const u32x2*)(blob + DNB_U + (((2 * kb) * 8 + nt) * 64 + lane) * 8), p1 = *(const u32x2*)(blob + DNB_U + (((2 * kb + 1) * 8 + nt) * 64 + lane) * 8); Vf[kb] = mk8(p0.x, p0.y, p1.x, p1.y); }
#pragma unroll
        for (int mt = 0; mt < 4; ++mt) { f32x4 acc = {0.f, 0.f, 0.f, 0.f};
#pragma unroll
            for (int kb = 0; kb < 4; ++kb) acc = mfma16(QF[mt][kb], Sf[kb], acc);
            acc = acc * eg[mt];
#pragma unroll
            for (int kb = 0; kb < 2; ++kb) acc = mfma16(QKF[mt][kb], Vf[kb], acc);
#pragma unroll
            for (int e = 0; e < 4; ++e) ODN[orow[mt][e] + 16 * nt] = f2bf(acc[e]); }
    }
}

template <int DIR> __device__ __forceinline__ void lru_item(const Args& a, int d, int n, int rt, int w, int lane, const bf16x8 (&XAall)[4][4], const bf16x8 (&WAf)[4], const bf16x8 (&WXf)[4]) {
    const int m = lane & 15, q = lane >> 4, r0 = rt * 64;
    const bf16* XC = (const bf16*)(a.ws + WS_XC); bf16* HLOC = (bf16*)(a.ws + WS_HLOC); bf16* CLB = (bf16*)(a.ws + WS_CL);
    float* AGG = (float*)(a.ws + WS_LAGG);
    bf16x8 id0, id1;
#pragma unroll
    for (int jj = 0; jj < 8; ++jj) { id0[jj] = (8 * q + jj == m) ? (short)0x3F80 : (short)0; id1[jj] = (8 * q + jj == 16 + m) ? (short)0x3F80 : (short)0; }
    f32x4 la[4], bb[4];
#pragma unroll
    for (int mt = 0; mt < 4; ++mt) { bf16x8 XA[4];
#pragma unroll
        for (int kb = 0; kb < 4; ++kb) XA[kb] = XAall[mt][kb];
        f32x4 ra = {0.f, 0.f, 0.f, 0.f}, rx = {0.f, 0.f, 0.f, 0.f};
#pragma unroll
        for (int kb = 0; kb < 4; ++kb) { ra = mfma16(XA[kb], WAf[kb], ra); rx = mfma16(XA[kb], WXf[kb], rx); }
        bb[mt] = mfma16((w >> 1) == 0 ? XA[0] : ((w >> 1) == 1 ? XA[1] : ((w >> 1) == 2 ? XA[2] : XA[3])), (w & 1) ? id1 : id0, (f32x4){0.f, 0.f, 0.f, 0.f});
        la[mt] = ra; const f32x4 t = rx;
        const int ch = 128 * n + 16 * w + m; const float ba = a.in[IN_LBA][d * 1024 + ch], bx = a.in[IN_LBX][d * 1024 + ch], sp = softplusf_(-a.in[IN_LAM][d * 1024 + ch]);
#pragma unroll
        for (int e = 0; e < 4; ++e) { const float rr = sigmoidf_(la[mt][e] + ba), gi = sigmoidf_(t[e] + bx), l = -8.0f * rr * sp; bb[mt][e] = sqrtf(1.0f - fexp(2.0f * l)) * gi * bb[mt][e]; la[mt][e] = l; }
    }
    f32x4 hl[4], cs[4]; float At[4], Ht[4];
#pragma unroll
    for (int mt = 0; mt < 4; ++mt) { float h = 0.f, c = 0.f;
#pragma unroll
        for (int ii = 0; ii < 4; ++ii) { const int e = DIR ? 3 - ii : ii; c += la[mt][e]; h = fexp(la[mt][e]) * h + bb[mt][e]; hl[mt][e] = h; cs[mt][e] = c; }
        At[mt] = c; Ht[mt] = h; }
    float hm = 0.f, am = 0.f;
#pragma unroll
    for (int bi = 0; bi < 4; ++bi) { const int mt = DIR ? 3 - bi : bi;
        float Aq[4], Hq[4];
#pragma unroll
        for (int k = 0; k < 4; ++k) { Aq[k] = __shfl(At[mt], m + 16 * k); Hq[k] = __shfl(Ht[mt], m + 16 * k); }
        float hc = 0.f, ac = 0.f, hb = 0.f, ab = 0.f;
#pragma unroll
        for (int kk = 0; kk < 4; ++kk) { const int k = DIR ? 3 - kk : kk; const bool before = DIR ? (k > q) : (k < q);
            if (before) { hc = fexp(Aq[k]) * hc + Hq[k]; ac += Aq[k]; }
            hb = fexp(Aq[k]) * hb + Hq[k]; ab += Aq[k]; }
        const float hin = fexp(ac) * hm + hc, ain = am + ac;
#pragma unroll
        for (int e = 0; e < 4; ++e) { const size_t o = ((size_t)d * MT + r0 + 16 * mt + 4 * q + e) * 1024 + 128 * n + 16 * w + m;
            HLOC[o] = f2bf(hl[mt][e] + fexp(cs[mt][e]) * hin); CLB[o] = f2bf(cs[mt][e] + ain); }
        hm = fexp(ab) * hm + hb; am += ab; }
    if (q == 0) { const int ch = 128 * n + 16 * w + m; AGG[((size_t)d * NCH + rt) * 1024 + ch] = am; AGG[((size_t)(2 + d) * NCH + rt) * 1024 + ch] = hm; }
}

__device__ __forceinline__ int scan_chunk(int s, int d) { return s < 4 ? 256 + (d ? 3 - s : s) : (d ? 255 - (s - 4) : (s - 4)); }
__device__ __forceinline__ void lru_carry(const Args& a, int id) {
    const int d = id >> 10, ch = id & 1023;
    const float* AGG = (const float*)(a.ws + WS_LAGG); float* CARRY = (float*)(a.ws + WS_LAGG) + (size_t)4 * NCH * 1024;
    float h = 0.f;
#pragma unroll 4
    for (int s = 0; s < NCH; ++s) { const int ck = scan_chunk(s, d);
        CARRY[((size_t)d * NCH + ck) * 1024 + ch] = h;
        h = fexp(AGG[((size_t)d * NCH + ck) * 1024 + ch]) * h + AGG[((size_t)(2 + d) * NCH + ck) * 1024 + ch]; }
}
__device__ __forceinline__ void ev_finish_row(const Args& a, int r, int lane, const bf16* ODN) {
    const bf16* PROJ = (const bf16*)(a.ws + WS_PROJ); const bf16* HL = (const bf16*)(a.ws + WS_HLOC); const bf16* CLB = (const bf16*)(a.ws + WS_CL); bf16* MIX = (bf16*)(a.ws + WS_MIX);
    const float* CARRY = (const float*)(a.ws + WS_LAGG) + (size_t)4 * NCH * 1024; const int ck = r >> 6;
#pragma unroll
    for (int it = 0; it < 2; ++it) {
        const int ch0 = (it * 64 + lane) * 8;
        float o0[8], o1[8], z[8], o[8]; unpack8(*(const u32x4*)(ODN + (size_t)r * 1024 + ch0), o0); unpack8(*(const u32x4*)(ODN + ((size_t)MT + r) * 1024 + ch0), o1);
        unpack8(*(const u32x4*)(PROJ + (size_t)r * NPROJ + 3072 + ch0), z);
        float ss = 0.f;
#pragma unroll
        for (int e = 0; e < 8; ++e) { o[e] = o0[e] + o1[e]; ss += o[e] * o[e]; }
        ss = sum16(ss); const float rstd = 1.0f / sqrtf(ss * (1.0f / 128.0f) + EPS);
        const f32x4 g0 = *(const f32x4*)(a.in[IN_DNG] + (ch0 & 127)), g1 = *(const f32x4*)(a.in[IN_DNG] + (ch0 & 127) + 4);
#pragma unroll
        for (int e = 0; e < 4; ++e) { o[e] = o[e] * rstd * g0[e] * siluf_(z[e]); o[4 + e] = o[4 + e] * rstd * g1[e] * siluf_(z[4 + e]); }
        *(u32x4*)(MIX + (size_t)r * D + ch0) = pack8(o);
    }
#pragma unroll
    for (int it = 0; it < 2; ++it) {
        const int ch0 = (it * 64 + lane) * 8;
        float h0[8], h1[8], c0[8], c1[8], gr[8], y[8]; unpack8(*(const u32x4*)(HL + (size_t)r * 1024 + ch0), h0); unpack8(*(const u32x4*)(HL + ((size_t)MT + r) * 1024 + ch0), h1);
        unpack8(*(const u32x4*)(CLB + (size_t)r * 1024 + ch0), c0); unpack8(*(const u32x4*)(CLB + ((size_t)MT + r) * 1024 + ch0), c1);
        unpack8(*(const u32x4*)(PROJ + (size_t)r * NPROJ + 5120 + ch0), gr);
        const f32x4 k00 = *(const f32x4*)(CARRY + (size_t)ck * 1024 + ch0), k01 = *(const f32x4*)(CARRY + (size_t)ck * 1024 + ch0 + 4);
        const f32x4 k10 = *(const f32x4*)(CARRY + ((size_t)NCH + ck) * 1024 + ch0), k11 = *(const f32x4*)(CARRY + ((size_t)NCH + ck) * 1024 + ch0 + 4);
#pragma unroll
        for (int e = 0; e < 8; ++e) { const float ka = e < 4 ? k00[e & 3] : k01[e & 3], kb = e < 4 ? k10[e & 3] : k11[e & 3];
            y[e] = ((h0[e] + fexp(c0[e]) * ka) + (h1[e] + fexp(c1[e]) * kb)) * gelu_tanh(gr[e]); }
        *(u32x4*)(MIX + (size_t)r * D + 1024 + ch0) = pack8(y);
    }
}

constexpr int GB_QD = 0, GB_KDT = 32768, GB_ATT = 65536, GB_EGL = 73728, GB_STRIDE = 74752;
constexpr int GCL_LD = 260;
__device__ __forceinline__ void gla_prep_unit(const Args& a, LAS unsigned char* lds, int tid, int unit) {
    const int c = unit % NCH, hd = unit / NCH, h = hd & 3, d = hd >> 2;
    const int lane = tid & 63, wave = __builtin_amdgcn_readfirstlane(tid >> 6), m = lane & 15, q = lane >> 4;
    const bf16* PROJ = (const bf16*)(a.ws + WS_PROJ); const float* AUX = (const float*)(a.ws + WS_AUX);
    unsigned char* blob = a.ws + WS_GLB + (size_t)unit * GB_STRIDE;
    LAS float* gcl = (LAS float*)lds;
    {
        LAS float* gds = gcl + 64 * GCL_LD;
        for (int i = tid; i < 64 * 16; i += NTHREADS) gds[i] = AUX[(size_t)scan_row(64 * c + (i >> 4), d) * 32 + d * 16 + (i & 15)];
        const int ch = tid & 255, half = tid >> 8;
        float wg[16];
#pragma unroll
        for (int r = 0; r < 16; ++r) wg[r] = a.in[IN_WG2][(size_t)(d * 16 + r) * 1024 + h * 256 + ch];
        const float bgc = a.in[IN_BG][d * 1024 + h * 256 + ch];
        __syncthreads();
        float run = 0.f;
#pragma unroll 4
        for (int pp = 0; pp < 32; ++pp) { const int p = 32 * half + pp; const LAS float* gd = gds + p * 16;
            const f32x4 g0 = *(const LAS f32x4*)(gd), g1 = *(const LAS f32x4*)(gd + 4), g2 = *(const LAS f32x4*)(gd + 8), g3 = *(const LAS f32x4*)(gd + 12);
            float lg = bgc;
#pragma unroll
            for (int r = 0; r < 4; ++r) { lg += g0[r] * wg[r]; lg += g1[r] * wg[4 + r]; lg += g2[r] * wg[8 + r]; lg += g3[r] * wg[12 + r]; }
            run += (fminf(lg, 0.f) - flog(1.0f + fexp(-fabsf(lg)))) * 0.0625f;
            gcl[p * GCL_LD + ch] = run; }
        __syncthreads();
        if (half) { const float tot = gcl[31 * GCL_LD + ch];
#pragma unroll 8
            for (int pp = 0; pp < 32; ++pp) gcl[(32 + pp) * GCL_LD + ch] += tot; }
        __syncthreads();
        if (tid < 256) ((float*)(blob + GB_EGL))[tid] = fexp(gcl[63 * GCL_LD + tid]);
    }
    size_t rrow[4];
#pragma unroll
    for (int t = 0; t < 4; ++t) rrow[t] = (size_t)scan_row(64 * c + 16 * t + m, d) * NPROJ + h * 256 + 8 * q;
    bf16x8 id0, id1;
#pragma unroll
    for (int jj = 0; jj < 8; ++jj) { id0[jj] = (8 * q + jj == m) ? (short)0x3F80 : (short)0; id1[jj] = (8 * q + jj == 16 + m) ? (short)0x3F80 : (short)0; }
    {
        bf16x8 qbf[8], kaf[8];
#pragma unroll
        for (int i = 0; i < 8; ++i) { const int tile = wave + 8 * i, it = tile >> 4, dt = tile & 15;
            qbf[i] = *(const bf16x8*)(PROJ + rrow[it] + 32 * (dt >> 1)); kaf[i] = *(const bf16x8*)(PROJ + rrow[it] + 1024 + 32 * (dt >> 1)); }
#pragma unroll
        for (int i = 0; i < 8; ++i) {
            const int tile = wave + 8 * i, it = tile >> 4, dt = tile & 15;
            {
                f32x4 dq = mfma16((dt & 1) ? id1 : id0, qbf[i], (f32x4){0.f, 0.f, 0.f, 0.f});
                const f32x4 gv = *(const LAS f32x4*)(gcl + (16 * it + m) * GCL_LD + 16 * dt + 4 * q);
#pragma unroll
                for (int e = 0; e < 4; ++e) dq[e] *= fexp(gv[e]) * 0.0625f;
                *(u32x2*)(blob + GB_QD + ((it * 8 + (dt >> 1)) * 64 + lane) * 16 + (dt & 1) * 8) = pack4(dq);
            }
            {
                f32x4 dk_ = mfma16(kaf[i], (dt & 1) ? id1 : id0, (f32x4){0.f, 0.f, 0.f, 0.f});
                const float gl = gcl[63 * GCL_LD + 16 * dt + m];
#pragma unroll
                for (int e = 0; e < 4; ++e) dk_[e] *= fexp(gl - gcl[(16 * it + 4 * q + e) * GCL_LD + 16 * dt + m]);
                *(u32x2*)(blob + GB_KDT + ((dt * 2 + (it >> 1)) * 64 + lane) * 16 + (it & 1) * 8) = pack4(dk_);
            }
        }
    }
    LAS f32x4* part = (LAS f32x4*)(lds + 70656);
    {
        bf16x8 KI[4], QDn[4];
#pragma unroll
        for (int t = 0; t < 4; ++t) { float kx[8], qx[8];
            unpack8(*(const u32x4*)(PROJ + rrow[t] + 1024 + 32 * wave), kx); unpack8(*(const u32x4*)(PROJ + rrow[t] + 32 * wave), qx);
            const f32x4 g0 = *(const LAS f32x4*)(gcl + (16 * t + m) * GCL_LD + 32 * wave + 8 * q), g1 = *(const LAS f32x4*)(gcl + (16 * t + m) * GCL_LD + 32 * wave + 8 * q + 4);
#pragma unroll
            for (int e = 0; e < 4; ++e) { kx[e] *= fexp(-g0[e]); kx[4 + e] *= fexp(-g1[e]); qx[e] *= fexp(g0[e]) * 0.0625f; qx[4 + e] *= fexp(g1[e]) * 0.0625f; }
            const u32x4 kp = pack8(kx), qp = pack8(qx); KI[t] = __builtin_bit_cast(bf16x8, kp); QDn[t] = __builtin_bit_cast(bf16x8, qp); }
        int ti = 0;
#pragma unroll
        for (int mt = 0; mt < 4; ++mt)
#pragma unroll
            for (int t = 0; t < 4; ++t) if (t <= mt) { part[(wave * 10 + ti) * 64 + lane] = mfma16(KI[t], QDn[mt], (f32x4){0.f, 0.f, 0.f, 0.f}); ++ti; }
    }
    __syncthreads();
    for (int ti = wave; ti < 10; ti += 8) {
        const int mt = ti >= 6 ? 3 : (ti >= 3 ? 2 : (ti >= 1 ? 1 : 0)), t = ti - mt * (mt + 1) / 2;
        f32x4 acc = part[ti * 64 + lane];
#pragma unroll
        for (int ww = 1; ww < 8; ++ww) acc += part[(ww * 10 + ti) * 64 + lane];
#pragma unroll
        for (int e = 0; e < 4; ++e) { const int j = 16 * t + 4 * q + e, i = 16 * mt + m; if (j > i) acc[e] = 0.f; }
        *(u32x2*)(blob + GB_ATT + ((mt * 2 + (t >> 1)) * 64 + lane) * 16 + (t & 1) * 8) = pack4(acc);
    }
    if (wave >= 2) { const int z = wave - 2, mt = z < 3 ? 0 : (z < 5 ? 1 : 2), t = z < 3 ? z + 1 : (z < 5 ? z - 1 : 3);
        *(u32x2*)(blob + GB_ATT + ((mt * 2 + (t >> 1)) * 64 + lane) * 16 + (t & 1) * 8) = (u32x2){0u, 0u}; }
    __syncthreads();
}

constexpr int GSEG = 8;
__device__ __forceinline__ int gseg_begin(int g) { return g == 0 ? 0 : 36 + 32 * (g - 1); }
template <int MODE> __device__ __forceinline__ void gla_scan(const Args& a, LAS unsigned char* lds, int tid, int h, int d, int qv, int g) {
    const int lane = tid & 63, w = __builtin_amdgcn_readfirstlane(tid >> 6), m = lane & 15, q = lane >> 4;
    const bf16* PROJ = (const bf16*)(a.ws + WS_PROJ); bf16* OG = (bf16*)(a.ws + WS_OGLA);
    const unsigned char* blob0 = a.ws + WS_GLB + (size_t)((d * 4 + h) * NCH) * GB_STRIDE;
    float* ZB = (float*)(a.ws + WS_GLZ); float* SEGDEC = (float*)(a.ws + WS_GLZ + 32 * MiB);
    const int c0 = gseg_begin(g), c1 = gseg_begin(g + 1);
    constexpr int NPIECE = GB_STRIDE / 16, P0 = MODE ? 0 : GB_KDT / 16, NSET = MODE ? 19 : 11;
    if (w >= 4) {
        const int lt = tid - 256;
        u32x4 ra[NSET], rb[NSET]; float prod = 1.0f;
#define GL_LOADSET(R, s_) do { if ((s_) < c1) { const unsigned char* bl_ = blob0 + (size_t)(s_) * GB_STRIDE; \
            _Pragma("unroll") for (int i = 0; i < NSET; ++i) { const int p = P0 + lt + 256 * i; if (p < NPIECE) R[i] = *(const u32x4*)(bl_ + p * 16); } \
            if (MODE == 0) prod *= *(const float*)(bl_ + GB_EGL + lt * 4); } } while (0)
#define GL_STORESET(R, s_) do { if ((s_) < c1) { LAS unsigned char* buf_ = lds + (((s_) - c0) & 1) * GB_STRIDE; \
            _Pragma("unroll") for (int i = 0; i < NSET; ++i) { const int p = P0 + lt + 256 * i; if (p < NPIECE) *(LAS u32x4*)(buf_ + p * 16) = R[i]; } } } while (0)
        GL_LOADSET(ra, c0); GL_LOADSET(rb, c0 + 1);
        GL_STORESET(ra, c0);
        LDS_BARRIER();
        for (int s = c0; s < c1; s += 2) {
            GL_LOADSET(ra, s + 2); GL_STORESET(rb, s + 1); LDS_BARRIER();
            GL_LOADSET(rb, s + 3); GL_STORESET(ra, s + 2); LDS_BARRIER();
        }
#undef GL_LOADSET
#undef GL_STORESET
        if (MODE == 0 && qv == 0) SEGDEC[((d * 4 + h) * GSEG + g) * 256 + lt] = prod;
        return;
    }
    const int colbase = 2048 + h * 512 + qv * 128 + 32 * w;
    bf16x8 id0, id1;
#pragma unroll
    for (int jj = 0; jj < 8; ++jj) { id0[jj] = (8 * q + jj == m) ? (short)0x3F80 : (short)0; id1[jj] = (8 * q + jj == 16 + m) ? (short)0x3F80 : (short)0; }
    f32x4 S[16][2];
#pragma unroll
    for (int i = 0; i < 16; ++i) { S[i][0] = (f32x4){0.f, 0.f, 0.f, 0.f}; S[i][1] = (f32x4){0.f, 0.f, 0.f, 0.f}; }
    if (MODE == 1) {
        for (int gp = 0; gp < g; ++gp) { const float* zp = ZB + ((size_t)((((d * 4 + h) * 4 + qv) * GSEG + gp) * 4 + w) * 32) * 256 + lane * 4; const float* dp = SEGDEC + ((d * 4 + h) * GSEG + gp) * 256 + 4 * q;
#pragma unroll
            for (int dt = 0; dt < 16; ++dt) { const f32x4 dc = *(const f32x4*)(dp + 16 * dt);
                S[dt][0] = S[dt][0] * dc + *(const f32x4*)(zp + (dt * 2 + 0) * 256); S[dt][1] = S[dt][1] * dc + *(const f32x4*)(zp + (dt * 2 + 1) * 256); } }
    }
    bf16x8 VA[4];
#pragma unroll
    for (int mt = 0; mt < 4; ++mt) VA[mt] = *(const bf16x8*)(PROJ + (size_t)scan_row(64 * c0 + 16 * mt + m, d) * NPROJ + colbase + 8 * q);
    LDS_BARRIER();
    for (int s = c0; s < c1; ++s) {
        const LAS unsigned char* buf = lds + ((s - c0) & 1) * GB_STRIDE;
        bf16x8 Vb[2][2];
#pragma unroll
        for (int nt = 0; nt < 2; ++nt) { f32x4 vc[4];
#pragma unroll
            for (int mt = 0; mt < 4; ++mt) vc[mt] = mfma16(VA[mt], nt ? id1 : id0, (f32x4){0.f, 0.f, 0.f, 0.f});
            Vb[nt][0] = pack_pair(vc[0], vc[1]); Vb[nt][1] = pack_pair(vc[2], vc[3]); }
        if (s + 1 < c1) {
#pragma unroll
            for (int mt = 0; mt < 4; ++mt) VA[mt] = *(const bf16x8*)(PROJ + (size_t)scan_row(64 * (s + 1) + 16 * mt + m, d) * NPROJ + colbase + 8 * q); }
        if (MODE == 1 && s >= 4) {
            f32x4 o[4][2];
#pragma unroll
            for (int mt = 0; mt < 4; ++mt) { o[mt][0] = (f32x4){0.f, 0.f, 0.f, 0.f}; o[mt][1] = (f32x4){0.f, 0.f, 0.f, 0.f}; }
            bf16x8 af[2][4];
#define GL_AFRAG(ks_, mt_) (*(const LAS bf16x8*)(buf + ((ks_) < 8 ? GB_QD + (((mt_) * 8 + (ks_)) * 64 + lane) * 16 : GB_ATT + (((mt_) * 2 + ((ks_) - 8)) * 64 + lane) * 16)))
#pragma unroll
            for (int mt = 0; mt < 4; ++mt) af[0][mt] = GL_AFRAG(0, mt);
#pragma unroll
            for (int ks = 0; ks < 10; ++ks) {
                if (ks + 1 < 10) {
#pragma unroll
                    for (int mt = 0; mt < 4; ++mt) af[(ks + 1) & 1][mt] = GL_AFRAG(ks + 1, mt); }
                bf16x8 b0, b1;
                if (ks < 8) { b0 = pack_pair(S[2 * (ks & 7)][0], S[2 * (ks & 7) + 1][0]); b1 = pack_pair(S[2 * (ks & 7)][1], S[2 * (ks & 7) + 1][1]); }
                else { b0 = Vb[0][ks & 1]; b1 = Vb[1][ks & 1]; }
#pragma unroll
                for (int mt = 0; mt < 4; ++mt) { o[mt][0] = mfma16(af[ks & 1][mt], b0, o[mt][0]); o[mt][1] = mfma16(af[ks & 1][mt], b1, o[mt][1]); }
            }
#undef GL_AFRAG
#pragma unroll
            for (int mt = 0; mt < 4; ++mt)
#pragma unroll
                for (int e = 0; e < 4; ++e) { const size_t ro = ((size_t)d * T + scan_row(64 * s + 16 * mt + 4 * q + e, d)) * D + (colbase - 2048) + m;
                    OG[ro] = f2bf(o[mt][0][e]); OG[ro + 16] = f2bf(o[mt][1][e]); }
        }
        {
            bf16x8 kf[2][2]; f32x4 egs[2];
            kf[0][0] = *(const LAS bf16x8*)(buf + GB_KDT + ((0 * 2 + 0) * 64 + lane) * 16); kf[0][1] = *(const LAS bf16x8*)(buf + GB_KDT + ((0 * 2 + 1) * 64 + lane) * 16);
            egs[0] = *(const LAS f32x4*)(buf + GB_EGL + (4 * q) * 4);
#pragma unroll
            for (int dt = 0; dt < 16; ++dt) {
                if (dt + 1 < 16) { kf[(dt + 1) & 1][0] = *(const LAS bf16x8*)(buf + GB_KDT + (((dt + 1) * 2 + 0) * 64 + lane) * 16); kf[(dt + 1) & 1][1] = *(const LAS bf16x8*)(buf + GB_KDT + (((dt + 1) * 2 + 1) * 64 + lane) * 16);
                    egs[(dt + 1) & 1] = *(const LAS f32x4*)(buf + GB_EGL + (16 * (dt + 1) + 4 * q) * 4); }
                f32x4 a0 = S[dt][0] * egs[dt & 1], a1 = S[dt][1] * egs[dt & 1];
                a0 = mfma16(kf[dt & 1][0], Vb[0][0], a0); a1 = mfma16(kf[dt & 1][0], Vb[1][0], a1);
                a0 = mfma16(kf[dt & 1][1], Vb[0][1], a0); a1 = mfma16(kf[dt & 1][1], Vb[1][1], a1);
                S[dt][0] = a0; S[dt][1] = a1; }
        }
        LDS_BARRIER();
    }
    if (MODE == 0) { float* zp = ZB + ((size_t)((((d * 4 + h) * 4 + qv) * GSEG + g) * 4 + w) * 32) * 256 + lane * 4;
#pragma unroll
        for (int dt = 0; dt < 16; ++dt) { *(f32x4*)(zp + (dt * 2 + 0) * 256) = S[dt][0]; *(f32x4*)(zp + (dt * 2 + 1) * 256) = S[dt][1]; } }
}

__device__ __forceinline__ void od_finish_row(const Args& a, int n, int lane) {
    const int p = (n & 63) * 256 + (n >> 6);
    const bf16* PROJ = (const bf16*)(a.ws + WS_PROJ); const bf16* OG = (const bf16*)(a.ws + WS_OGLA); bf16* MIX = (bf16*)(a.ws + WS_MIX);
#pragma unroll
    for (int it = 0; it < 4; ++it) {
        const int ch0 = it * 512 + lane * 8;
        float o0[8], o1[8], go[8], o[8]; unpack8(*(const u32x4*)(OG + (size_t)p * D + ch0), o0); unpack8(*(const u32x4*)(OG + ((size_t)T + p) * D + ch0), o1);
        unpack8(*(const u32x4*)(PROJ + (size_t)p * NPROJ + 4096 + ch0), go);
        float ss = 0.f;
#pragma unroll
        for (int e = 0; e < 8; ++e) { o[e] = o0[e] + o1[e]; ss += o[e] * o[e]; }
        ss = wave_sum(ss); const float rstd = 1.0f / sqrtf(ss * (1.0f / 512.0f) + EPS);
        const f32x4 g0 = *(const f32x4*)(a.in[IN_GLAG] + lane * 8), g1 = *(const f32x4*)(a.in[IN_GLAG] + lane * 8 + 4);
#pragma unroll
        for (int e = 0; e < 4; ++e) { o[e] = o[e] * rstd * g0[e] * siluf_(go[e]); o[4 + e] = o[4 + e] * rstd * g1[e] * siluf_(go[4 + e]); }
        *(u32x4*)(MIX + (size_t)n * D + ch0) = pack8(o);
    }
}

__global__ void __launch_bounds__(NTHREADS, 2) fwd_kernel(Args args) {
    extern __shared__ __attribute__((aligned(16))) unsigned char lds_raw[];
    LAS unsigned char* lds = (LAS unsigned char*)lds_raw;
    const int tid = threadIdx.x, lane = tid & 63, wave = __builtin_amdgcn_readfirstlane(tid >> 6);
    const int G = gridDim.x, gw = blockIdx.x * NWAVES + wave, NGW = G * NWAVES;
    unsigned char* ws = args.ws;
    unsigned* ctl = (unsigned*)(ws + WS_CTL);
    volatile LAS unsigned* MISC = (volatile LAS unsigned*)(lds + LDSCTL_OFF);
    for (int u = tid; u < (LDS_BYTES - LDSCTL_OFF) / 4; u += NTHREADS) ((LAS unsigned*)(lds + LDSCTL_OFF))[u] = 0u;
    __syncthreads();
    XcdBarrier bar = xcd_barrier_post(ctl + CW_BAR, MISC + 8);
#define GRID_BAR() xcd_barrier(bar)
    const int lo = args.ph_lo, hi = args.ph_hi;
#define IN(k) (lo <= (k) && (k) < hi)
#define BOTH(k) (IN(k) && IN((k) + 1))
    float* MOD = (float*)(ws + WS_MOD);
#define MODV(layer, cond, j) (MOD + (((layer) * 2 + (cond)) * 6 + (j)) * D)
    float* XRES = (float*)(ws + WS_XRES);
    bf16* H = (bf16*)(ws + WS_H);
    bf16* MIX = (bf16*)(ws + WS_MIX);

    if (IN(0)) {
        p0_adaln(args, lds, tid, 0, (int)blockIdx.x, G);
        LAS float* scr = (LAS float*)(lds + wave * 16384);
        transpose_job<3>(args.in[IN_EVWIN], D, EV_IN, (bf16*)(ws + WS_W_EVIN), scr, gw, NGW, lane);
        { bf16* WT = (bf16*)(ws + WS_SMALL + SM_LRUW);
          for (int i = blockIdx.x * NTHREADS + tid; i < 2 * 8 * 2 * 128 * 128; i += G * NTHREADS) { const int c = i & 127, mm = (i >> 7) & 127, mat = (i >> 14) & 1, dn = i >> 15;
              WT[i] = f2bf((mat ? args.in[IN_LWX] : args.in[IN_LWA])[((size_t)dn * 128 + c) * 128 + mm]); } }
        if (BOTH(0)) GRID_BAR();
    }
    if (IN(1)) {
        LAS float* nA = (LAS float*)lds; LAS float* nB = nA + D;
        norm_stage_ab(nA, nB, args.in[IN_N1G], MODV(0, 0, 0), MODV(0, 0, 1), tid); __syncthreads();
        for (int r = gw; r < MT; r += NGW) { const int cond = r >= T; f32x4 hv[8];
            if (cond) norm_row(args.in[IN_CTX] + (size_t)(r - T) * D, args.in[IN_N1G], MODV(0, 1, 0), MODV(0, 1, 1), H + (size_t)r * D, nullptr, lane, hv);
            else norm_row_ab(args.in[IN_X] + (size_t)r * D, nA, nB, H + (size_t)r * D, lane, hv); }
        if (BOTH(1)) GRID_BAR();
    }
    if (IN(2)) {
        if ((int)blockIdx.x < XC_GW2) {
        pg8::Gemm g{H, (const bf16*)(ws + WS_W_EVIN), MT, NPROJ_PAD, D, D}; pg8::StaticOrder S; S.init(MT, NPROJ_PAD, XC_GW2, (int)blockIdx.x);
        pg8::EpiProj E{(bf16*)(ws + WS_PROJ), (float*)(ws + WS_AUX), NPROJ, NPROJ / 256};
        pg8::gemm_phase<pg8::EpiProj, pg8::StaticOrder, true, true>(lds, g, S, E);
        } else expert_convert_range(args, (LAS float*)(lds + wave * 16384), XC_B0, XC_B1, ((int)blockIdx.x - XC_GW2) * NWAVES + wave, (G - XC_GW2) * NWAVES, lane);
        if (BOTH(2)) GRID_BAR();
    }
    if (IN(3)) {
        { LAS float* cwq = (LAS float*)lds; LAS float* cwl = cwq + 4 * 3072; LAS float* cbl = cwl + 4 * 1024;
          for (int i = tid; i < 3072; i += NTHREADS) ((LAS f32x4*)cwq)[i] = ((const f32x4*)args.in[IN_EVCONV])[i];
          for (int i = tid; i < 1024; i += NTHREADS) ((LAS f32x4*)cwl)[i] = ((const f32x4*)args.in[IN_LCW])[i];
          for (int i = tid; i < 256; i += NTHREADS) ((LAS f32x4*)cbl)[i] = ((const f32x4*)args.in[IN_LCB])[i];
          __syncthreads();
          u32x4 xa[2][4], xb[2][4]; int r = gw;
          if (r < MT) ev_prep_load(args, r, 0, lane, xa);
          while (r < MT) { const int rn = r + NGW;
              ev_prep_load(args, r, 1, lane, xb); ev_prep_compute(args, r, 0, lane, xa, cwq, cwl, cbl);
              ev_prep_load(args, r, 2, lane, xa); ev_prep_compute(args, r, 1, lane, xb, cwq, cwl, cbl);
              ev_prep_load(args, r, 3, lane, xb); ev_prep_compute(args, r, 2, lane, xa, cwq, cwl, cbl);
              if (rn < MT) ev_prep_load(args, rn, 0, lane, xa);
              ev_prep_compute(args, r, 3, lane, xb, cwq, cwl, cbl); r = rn; } }
        if (BOTH(3)) GRID_BAR();
    }
    if (IN(4)) {
        {
            const bf16* XC = (const bf16*)(ws + WS_XC); const unsigned* WT32 = (const unsigned*)(ws + WS_SMALL + SM_LRUW); const int m_ = lane & 15, q_ = lane >> 4;
            const int dn = (int)blockIdx.x >> 4, n = dn & 7, d = dn >> 3;
            bf16x8 WAf[4], WXf[4];
#pragma unroll
            for (int kb = 0; kb < 4; ++kb) { const unsigned* pa = WT32 + (((size_t)((dn * 2 + 0) * 128 + 16 * wave + m_)) * 128 + 32 * kb + 8 * q_) / 2; const unsigned* px = WT32 + (((size_t)((dn * 2 + 1) * 128 + 16 * wave + m_)) * 128 + 32 * kb + 8 * q_) / 2;
                u32x4 va, vx;
#pragma unroll
                for (int j = 0; j < 4; ++j) { va[j] = __hip_atomic_load(pa + j, __ATOMIC_RELAXED, __HIP_MEMORY_SCOPE_AGENT); vx[j] = __hip_atomic_load(px + j, __ATOMIC_RELAXED, __HIP_MEMORY_SCOPE_AGENT); }
                WAf[kb] = __builtin_bit_cast(bf16x8, va); WXf[kb] = __builtin_bit_cast(bf16x8, vx); }
            bf16x8 XAc[4][4];
#define LRU_XLOAD(X, rt_) do { _Pragma("unroll") for (int mt = 0; mt < 4; ++mt) _Pragma("unroll") for (int kb = 0; kb < 4; ++kb) \
                X[mt][kb] = *(const bf16x8*)(XC + (size_t)((rt_) * 64 + 16 * mt + m_) * 1024 + 128 * n + 32 * kb + 8 * q_); } while (0)
            for (int rt = (int)blockIdx.x & 15; rt < NCH; rt += 16) {
                LRU_XLOAD(XAc, rt);
                if (d) lru_item<1>(args, d, n, rt, wave, lane, XAc, WAf, WXf); else lru_item<0>(args, d, n, rt, wave, lane, XAc, WAf, WXf);
            }
#undef LRU_XLOAD
        }
        if (BOTH(4)) GRID_BAR();
    }
    if (IN(5)) {
        for (int u = gw; u < 16 * NCH; u += NGW) dn_prep_unit(args, lds + wave * DN_WAVE_LDS, u, lane);
        GRID_BAR();
        const int b = blockIdx.x;
        if (b < 64) dn_scan2(args, lds, tid, (b >> 2) & 7, b >> 5, b & 3);
        else if (b < 68) lru_carry(args, (b - 64) * NTHREADS + tid);
        else {
            p0_adaln(args, lds, tid, 1, b - 68, G - 68);
            LAS float* scr = (LAS float*)(lds + wave * 16384); const int gw2 = (b - 68) * NWAVES + wave, ngw2 = (G - 68) * NWAVES;
            transpose_job<0>(args.in[IN_EVWOUT], D, D, (bf16*)(ws + WS_W_EVOUT), scr, gw2, ngw2, lane);
            transpose_job<1>(args.in[IN_EVGATE], D, FF, (bf16*)(ws + WS_W_EVGU), scr, gw2, ngw2, lane);
            transpose_job<2>(args.in[IN_EVUP], D, FF, (bf16*)(ws + WS_W_EVGU), scr, gw2, ngw2, lane);
            transpose_job<0>(args.in[IN_EVDOWN], FF, D, (bf16*)(ws + WS_W_EVDN), scr, gw2, ngw2, lane);
            transpose_job<0>(args.in[IN_ODWIN], D, EV_IN, (bf16*)(ws + WS_W_ODIN), scr, gw2, ngw2, lane);
            transpose_job<0>(args.in[IN_ODWOUT], D, D, (bf16*)(ws + WS_W_ODOUT), scr, gw2, ngw2, lane);
        }
        GRID_BAR();
        for (int u = gw; u < 16 * NCH; u += NGW) dn_out_unit(args, u, lane);
        if (BOTH(5)) GRID_BAR();
    }
    if (IN(6)) {
        for (int r = gw; r < MT; r += NGW) ev_finish_row(args, r, lane, (const bf16*)(ws + WS_ODN));
        if (BOTH(6)) GRID_BAR();
    }
    if (IN(7)) {
        if ((int)blockIdx.x < XC_GW7) {
        pg8::Gemm g{MIX, (const bf16*)(ws + WS_W_EVOUT), MT, D, D, D}; pg8::StaticOrder S; S.init(MT, D, XC_GW7, (int)blockIdx.x);
        pg8::EpiResid E{XRES, MODV(0, 0, 2), MODV(0, 1, 2), args.in[IN_X], args.in[IN_CTX]};
        pg8::gemm_phase<pg8::EpiResid, pg8::StaticOrder, true, true>(lds, g, S, E);
        } else expert_convert_range(args, (LAS float*)(lds + wave * 16384), XC_B1, XC_B2, ((int)blockIdx.x - XC_GW7) * NWAVES + wave, (G - XC_GW7) * NWAVES, lane);
        if (BOTH(7)) GRID_BAR();
    }
    if (IN(8)) {
        LAS float* nA = (LAS float*)lds; LAS float* nB = nA + D;
        norm_stage_ab(nA, nB, args.in[IN_N2G], MODV(0, 0, 3), MODV(0, 0, 4), tid); __syncthreads();
        for (int r = gw; r < MT; r += NGW) { const int cond = r >= T; f32x4 hv[8];
            if (cond) norm_row(XRES + (size_t)r * D, args.in[IN_N2G], MODV(0, 1, 3), MODV(0, 1, 4), H + (size_t)r * D, nullptr, lane, hv);
            else norm_row_ab(XRES + (size_t)r * D, nA, nB, H + (size_t)r * D, lane, hv); }
        if (BOTH(8)) GRID_BAR();
    }
    if (IN(9)) {
        if ((int)blockIdx.x < XC_GW9) {
        pg8::Gemm g{H, (const bf16*)(ws + WS_W_EVGU), MT, 2 * FF, D, D}; pg8::StaticOrder S; S.init(MT, 2 * FF, XC_GW9, (int)blockIdx.x);
        pg8::EpiSwiglu E{(bf16*)(ws + WS_HID), FF, 2 * FF / 256};
        pg8::gemm_phase<pg8::EpiSwiglu, pg8::StaticOrder, true, true>(lds, g, S, E);
        } else expert_convert_range(args, (LAS float*)(lds + wave * 16384), XC_B2, XC_B3, ((int)blockIdx.x - XC_GW9) * NWAVES + wave, (G - XC_GW9) * NWAVES, lane);
        if (BOTH(9)) GRID_BAR();
    }
    if (IN(10)) {
        if ((int)blockIdx.x < XC_GW10) {
        pg8::Gemm g{(const bf16*)(ws + WS_HID), (const bf16*)(ws + WS_W_EVDN), MT, D, FF, FF}; pg8::StaticOrder S; S.init(MT, D, XC_GW10, (int)blockIdx.x);
        pg8::EpiResid E{XRES, MODV(0, 0, 5), MODV(0, 1, 5), nullptr, nullptr};
        pg8::gemm_phase<pg8::EpiResid, pg8::StaticOrder, true, true>(lds, g, S, E);
        } else expert_convert_range(args, (LAS float*)(lds + wave * 16384), XC_B3, XC_B4, ((int)blockIdx.x - XC_GW10) * NWAVES + wave, (G - XC_GW10) * NWAVES, lane);
        if (BOTH(10)) GRID_BAR();
    }
    if (IN(11)) {
        LAS float* nA = (LAS float*)lds; LAS float* nB = nA + D;
        norm_stage_ab(nA, nB, args.in[IN_N1G] + D, MODV(1, 0, 0), MODV(1, 0, 1), tid); __syncthreads();
        for (int r = gw; r < MT; r += NGW) { const int cond = r >= T; f32x4 hv[8];
            const int dstr = cond ? r : ((r & 63) * 256 + (r >> 6));
            if (cond) norm_row(XRES + (size_t)r * D, args.in[IN_N1G] + D, MODV(1, 1, 0), MODV(1, 1, 1), H + (size_t)dstr * D, nullptr, lane, hv);
            else norm_row_ab(XRES + (size_t)r * D, nA, nB, H + (size_t)dstr * D, lane, hv); }
        if (BOTH(11)) GRID_BAR();
    }
    if (IN(12)) {
        if ((int)blockIdx.x < XC_GW12) {
        pg8::Gemm g{H, (const bf16*)(ws + WS_W_ODIN), MT, NPROJ_PAD, D, D}; pg8::StaticOrder S; S.init(MT, NPROJ_PAD, XC_GW12, (int)blockIdx.x);
        pg8::EpiProj E{(bf16*)(ws + WS_PROJ), (float*)(ws + WS_AUX), NPROJ, NPROJ / 256};
        pg8::gemm_phase<pg8::EpiProj, pg8::StaticOrder, true, true>(lds, g, S, E);
        } else expert_convert_range(args, (LAS float*)(lds + wave * 16384), XC_B4, XC_B5, ((int)blockIdx.x - XC_GW12) * NWAVES + wave, (G - XC_GW12) * NWAVES, lane);
        if (BOTH(12)) GRID_BAR();
    }
    if (IN(13)) {
        const int b = blockIdx.x;
        for (int u = b; u < 8 * NCH; u += G) gla_prep_unit(args, lds, tid, u);
        GRID_BAR();
        { const int g = b & 7, qv = (b >> 3) & 3, hh = (b >> 5) & 3, dd = b >> 7;
          if (b < 256 && g < GSEG - 1) gla_scan<0>(args, lds, tid, hh, dd, qv, g);
          GRID_BAR();
          if (b < 256) gla_scan<1>(args, lds, tid, hh, dd, qv, g); }
        if (BOTH(13)) GRID_BAR();
    }
    if (IN(14)) {
        for (int n = gw; n < T; n += NGW) od_finish_row(args, n, lane);
        if (BOTH(14)) GRID_BAR();
    }
    if (IN(15)) {
        pg8::Gemm g{MIX, (const bf16*)(ws + WS_W_ODOUT), T, D, D, D}; pg8::StaticOrder S; S.init(T, D, G, (int)blockIdx.x);
        pg8::EpiResid E{XRES, MODV(1, 0, 2), MODV(1, 1, 2), nullptr, nullptr};
        pg8::gemm_phase<pg8::EpiResid, pg8::StaticOrder, true, true>(lds, g, S, E);
        if (BOTH(15)) GRID_BAR();
    }
    int* TOPI = (int*)(ws + WS_SMALL + SM_TOPI); float* TOPW = (float*)(ws + WS_SMALL + SM_TOPW); int* POS = (int*)(ws + WS_SMALL + SM_POS);
    int* SLOT = (int*)(ws + WS_SMALL + SM_SLOT); int* WGBASE = (int*)(ws + WS_SMALL + SM_WGBASE);
    if (IN(16)) {
        LAS int* hist = (LAS int*)lds;
        LAS float* rws = (LAS float*)(lds + 1024);
        for (int i = tid; i < D * 8 / 4; i += NTHREADS) ((LAS f32x4*)rws)[i] = ((const f32x4*)args.in[IN_RW])[i];
        LAS float* nA = (LAS float*)(lds + 1024 + 65536); LAS float* nB = nA + D;
        norm_stage_ab(nA, nB, args.in[IN_N2G] + D, MODV(1, 0, 3), MODV(1, 0, 4), tid);
        if (tid < 8) hist[tid] = 0;
        { int* ROWMAP = (int*)(ws + WS_SMALL + SM_ROWMAP); for (int i = blockIdx.x * NTHREADS + tid; i < XS_ROWS; i += G * NTHREADS) ROWMAP[i] = 0; }
        __syncthreads();
        int wcnt[8];
#pragma unroll
        for (int e = 0; e < 8; ++e) wcnt[e] = 0;
        for (int n = gw; n < T; n += NGW) { f32x4 hv[8];
            asm volatile("" ::: "memory");
            norm_row_ab(XRES + (size_t)n * D, nA, nB, H + (size_t)n * D, lane, hv);
            float lg[8];
#pragma unroll
            for (int e = 0; e < 8; ++e) lg[e] = 0.f;
#pragma unroll
            for (int j = 0; j < 8; ++j)
#pragma unroll
                for (int q = 0; q < 4; ++q) { const int c = 4 * lane + 256 * j + q; const f32x4 w0 = *(const LAS f32x4*)(rws + c * 8), w1 = *(const LAS f32x4*)(rws + c * 8 + 4);
                    const float x = hv[j][q];
#pragma unroll
                    for (int e = 0; e < 4; ++e) { lg[e] += x * w0[e]; lg[4 + e] += x * w1[e]; } }
#pragma unroll
            for (int e = 0; e < 8; ++e) lg[e] = wave_sum(lg[e]) + args.in[IN_RB][e];
            if (lane == 0) {
                int i0 = 0; float l0 = lg[0];
#pragma unroll
                for (int e = 1; e < 8; ++e) if (lg[e] > l0) { l0 = lg[e]; i0 = e; }
                int i1 = -1; float l1 = -3.0e38f;
#pragma unroll
                for (int e = 0; e < 8; ++e) if (e != i0 && lg[e] > l1) { l1 = lg[e]; i1 = e; }
                if (i1 < 0) i1 = (i0 + 1) & 7;
                const float w0 = 1.0f / (1.0f + fexp(l1 - l0));
                TOPI[2 * n] = i0; TOPI[2 * n + 1] = i1; TOPW[2 * n] = w0; TOPW[2 * n + 1] = 1.0f - w0;
                int p0 = 0, p1 = 0;
#pragma unroll
                for (int e = 0; e < 8; ++e) { if (e == i0) { p0 = wcnt[e]; wcnt[e] += 1; } }
#pragma unroll
                for (int e = 0; e < 8; ++e) { if (e == i1) { p1 = wcnt[e]; wcnt[e] += 1; } }
                POS[2 * n] = p0; POS[2 * n + 1] = p1;
            }
        }
        if (lane == 0) {
#pragma unroll
            for (int e = 0; e < 8; ++e) hist[8 + wave * 8 + e] = wcnt[e]; }
        __syncthreads();
        if (tid < 8) { int run = 0; int* WVPRE = (int*)(ws + WS_SMALL + SM_WVPRE);
            for (int w2 = 0; w2 < 8; ++w2) { WVPRE[(blockIdx.x * 8 + w2) * 8 + tid] = run; run += hist[8 + w2 * 8 + tid]; }
            ((int*)(ws + WS_SMALL + SM_WGCNT))[blockIdx.x * 8 + tid] = run; atomicAdd(ctl + CW_CNT + tid, (unsigned)run); }
        if (BOTH(16)) GRID_BAR();
    }
    int tend[8]; int Mt = 0; int pstart[8];
    if (hi > 17) {
#pragma unroll
        for (int e = 0; e < 8; ++e) { const int c = (int)__hip_atomic_load(ctl + CW_CNT + e, __ATOMIC_RELAXED, __HIP_MEMORY_SCOPE_AGENT); pstart[e] = Mt * 256; Mt += (c + 255) >> 8; tend[e] = Mt; }
    }
    if (IN(17)) {
        int* ROWMAP = (int*)(ws + WS_SMALL + SM_ROWMAP); const int* WVPRE = (const int*)(ws + WS_SMALL + SM_WVPRE); const int* WGCNT = (const int*)(ws + WS_SMALL + SM_WGCNT);
        LAS int* wgpre = (LAS int*)lds;
        if (tid < 8) { int run = 0; for (int w2 = 0; w2 < G; ++w2) { wgpre[w2 * 8 + tid] = run; run += WGCNT[w2 * 8 + tid]; } }
        __syncthreads();
        for (int n = blockIdx.x * NTHREADS + tid; n < T; n += G * NTHREADS) {
            const int gwn = n % NGW;
#pragma unroll
            for (int k = 0; k < 2; ++k) { const int e = TOPI[2 * n + k]; int ps = 0;
#pragma unroll
                for (int q = 0; q < 8; ++q) ps = (q == e) ? pstart[q] : ps;
                const int slot = ps + wgpre[(gwn / NWAVES) * 8 + e] + WVPRE[gwn * 8 + e] + POS[2 * n + k];
                SLOT[2 * n + k] = slot; ROWMAP[slot] = n; }
        }
        if (BOTH(17)) GRID_BAR();
    }
    if (IN(18)) {
        pg8::Gemm g{H, (const bf16*)(ws + WS_W_XGU), Mt * 256, 2 * FF, D, D};
        pg8::MoeOrder S; S.nN = 2 * FF / 256; S.Mt = Mt; S.nwg = Mt * S.nN; S.G = G; S.c = (int)blockIdx.x;
#pragma unroll
        for (int e = 0; e < 8; ++e) S.tend[e] = tend[e];
        pg8::EpiSwiglu E{(bf16*)(ws + WS_HID2), FF, 2 * FF / 256};
        pg8::gemm_phase_gather<pg8::EpiSwiglu, pg8::MoeOrder>(lds, g, (const int*)(ws + WS_SMALL + SM_ROWMAP), S, E);
        if (BOTH(18)) GRID_BAR();
    }
    if (IN(19)) {
        const int Mmain = Mt < 128 ? Mt : 128;
        { pg8::Gemm g{(const bf16*)(ws + WS_HID2), (const bf16*)(ws + WS_W_XDN), Mmain * 256, D, FF, FF};
          pg8::MoeOrder S; S.nN = D / 256; S.Mt = Mmain; S.nwg = Mmain * S.nN; S.G = G; S.c = (int)blockIdx.x;
#pragma unroll
          for (int e = 0; e < 8; ++e) S.tend[e] = tend[e];
          pg8::EpiBf16N E{(bf16*)(ws + WS_YB), D, D / 256};
          pg8::gemm_phase<pg8::EpiBf16N, pg8::MoeOrder, true, true>(lds, g, S, E); }
        if (Mt > 128) {
          pg8::Gemm g{(const bf16*)(ws + WS_HID2), (const bf16*)(ws + WS_W_XDN), Mt * 256, D, FF / 4, FF};
          pg8::MoeSplitOrder S; S.nN = D / 256; S.tile0 = 128; S.Mt = Mt; S.KS = 4; S.Ksub = FF / 4; S.nwg = (Mt - 128) * S.nN * 4; S.G = G; S.c = (int)blockIdx.x;
#pragma unroll
          for (int e = 0; e < 8; ++e) S.tend[e] = tend[e];
          pg8::EpiF32Part E{(float*)(ws + WS_YBX), 128 * 256, 8 * 256, D, D / 256, FF / 4};
          pg8::gemm_phase<pg8::EpiF32Part, pg8::MoeSplitOrder, true, true>(lds, g, S, E); }
        if (BOTH(19)) GRID_BAR();
    }
    if (IN(20)) {
        const bf16* YB = (const bf16*)(ws + WS_YB); const float* YBX = (const float*)(ws + WS_YBX);
        LAS float* gt2 = (LAS float*)lds; LAS float* fng = gt2 + D;
        for (int i = tid; i < D; i += NTHREADS) { gt2[i] = MODV(1, 0, 5)[i]; fng[i] = args.in[IN_FNG][i]; }
        __syncthreads();
        for (int n = gw; n < T; n += NGW) {
            const int s0 = SLOT[2 * n], s1 = SLOT[2 * n + 1]; const float w0 = TOPW[2 * n], w1 = TOPW[2 * n + 1];
            f32x4 v[8]; float ss = 0.f;
#pragma unroll
            for (int j = 0; j < 8; ++j) { const int c = 4 * lane + 256 * j;
                f32x4 ya, yb;
                if (s0 < 32768) { const u32x2 a0 = *(const u32x2*)(YB + (size_t)s0 * D + c); ya = (f32x4){bf2f(a0.x & 0xffffu), bf2f(a0.x >> 16), bf2f(a0.y & 0xffffu), bf2f(a0.y >> 16)}; }
                else { const float* pp = YBX + (size_t)(s0 - 32768) * D + c; ya = (*(const f32x4*)pp + *(const f32x4*)(pp + (size_t)2048 * D)) + (*(const f32x4*)(pp + (size_t)4096 * D) + *(const f32x4*)(pp + (size_t)6144 * D)); }
                if (s1 < 32768) { const u32x2 a1 = *(const u32x2*)(YB + (size_t)s1 * D + c); yb = (f32x4){bf2f(a1.x & 0xffffu), bf2f(a1.x >> 16), bf2f(a1.y & 0xffffu), bf2f(a1.y >> 16)}; }
                else { const float* pp = YBX + (size_t)(s1 - 32768) * D + c; yb = (*(const f32x4*)pp + *(const f32x4*)(pp + (size_t)2048 * D)) + (*(const f32x4*)(pp + (size_t)4096 * D) + *(const f32x4*)(pp + (size_t)6144 * D)); }
                const f32x4 y = ya * w0 + yb * w1;
                v[j] = *(const f32x4*)(XRES + (size_t)n * D + c) + *(const LAS f32x4*)(gt2 + c) * y;
                ss += (v[j][0] * v[j][0] + v[j][1] * v[j][1]) + (v[j][2] * v[j][2] + v[j][3] * v[j][3]); }
            const float rstd = 1.0f / sqrtf(wave_sum(ss) * (1.0f / D) + EPS);
#pragma unroll
            for (int j = 0; j < 8; ++j) { const int c = 4 * lane + 256 * j; f32x4 ov = v[j] * rstd * *(const LAS f32x4*)(fng + c);
                *(f32x4*)(args.out + (size_t)n * D + c) = ov; }
        }
    }
#undef IN
#undef BOTH
}

extern "C" void kernel_launch(void* const* d_in, const int* in_sizes, int n_in, void* d_out, int out_size, void* d_ws, size_t ws_size, hipStream_t stream) {
    static int grid = 0;
    if (grid == 0) {
        if (n_in != N_IN || out_size != T * D || ws_size < (WS_END > WS_L0_END ? WS_END : WS_L0_END)) { fprintf(stderr, "kernel_launch: unexpected shapes (n_in %d, out %d, ws %zu)\n", n_in, out_size, ws_size); grid = -1; return; }
        int dev = 0, cus = 0, per_cu = 0;
        if (hipGetDevice(&dev) != hipSuccess || hipDeviceGetAttribute(&cus, hipDeviceAttributeMultiprocessorCount, dev) != hipSuccess) { grid = -1; return; }
        if (hipFuncSetAttribute((const void*)fwd_kernel, hipFuncAttributeMaxDynamicSharedMemorySize, LDS_BYTES) != hipSuccess) { fprintf(stderr, "kernel_launch: hipFuncSetAttribute failed\n"); grid = -1; return; }
        if (hipOccupancyMaxActiveBlocksPerMultiprocessor(&per_cu, (const void*)fwd_kernel, NTHREADS, LDS_BYTES) != hipSuccess || per_cu < 1) fprintf(stderr, "kernel_launch: occupancy query says %d\n", per_cu);
        (void)hipGetLastError();
        grid = cus;
    }
    if (grid < 0) return;
    (void)hipMemsetAsync((char*)d_ws + WS_CTL, 0, CTL_BYTES, stream);
    Args a{};
    for (int i = 0; i < N_IN; ++i) a.in[i] = (const float*)d_in[i];
    a.out = (float*)d_out; a.ws = (unsigned char*)d_ws;
    a.ph_lo = 0; a.ph_hi = N_PHASES;
    hipLaunchKernelGGL(fwd_kernel, dim3(grid), dim3(NTHREADS), LDS_BYTES, stream, a);
}
```

```cpp
#include <hip/hip_runtime.h>
#include <cstdio>
#include <cstdint>

#define GAS __attribute__((address_space(1)))
#define LAS __attribute__((address_space(3)))
typedef unsigned short bf16;
typedef float f32x4 __attribute__((ext_vector_type(4)));
typedef float f32x2 __attribute__((ext_vector_type(2)));
typedef unsigned u32x4 __attribute__((ext_vector_type(4)));
typedef unsigned u32x2 __attribute__((ext_vector_type(2)));
typedef short bf16x8 __attribute__((ext_vector_type(8)));

constexpr int D = 2048, T = 16384, CT = 256, MT = T + CT, FF = 5632;
constexpr int NPROJ = 6144, NPROJ_PAD = 6400, EV_IN = 6176;
constexpr int NEXP = 8;
constexpr float EPS = 1e-6f;
constexpr int XS_ROWS = 34816;

constexpr size_t MiB = 1u << 20;
constexpr size_t WS_CTL = 0, CTL_BYTES = 1 * MiB;
constexpr size_t WS_MOD = 1 * MiB;
constexpr size_t WS_SMALL = 2 * MiB;
constexpr size_t WS_W_EVIN = 4 * MiB;
constexpr size_t WS_W_EVOUT = WS_W_EVIN + 25 * MiB;
constexpr size_t WS_W_EVGU = WS_W_EVOUT + 8 * MiB;
constexpr size_t WS_W_EVDN = WS_W_EVGU + 44 * MiB;
constexpr size_t WS_W_ODIN = WS_W_EVDN + 22 * MiB;
constexpr size_t WS_W_ODOUT = WS_W_ODIN + 25 * MiB;
constexpr size_t WS_W_XGU = WS_W_ODOUT + 8 * MiB;
constexpr size_t WS_W_XDN = WS_W_XGU + 352 * MiB;
constexpr size_t WS_XRES = WS_W_XDN + 176 * MiB;
constexpr size_t WS_H = WS_XRES + 130 * MiB;
constexpr size_t WS_S = WS_H + 65 * MiB;
constexpr size_t WS_PROJ = WS_S;
constexpr size_t WS_AUX = WS_S + 195 * MiB;
constexpr size_t WS_QN = WS_AUX + 3 * MiB;
constexpr size_t WS_KN = WS_QN + 33 * MiB;
constexpr size_t WS_VC = WS_KN + 33 * MiB;
constexpr size_t WS_XC = WS_VC + 33 * MiB;
constexpr size_t WS_GB = WS_XC + 33 * MiB;
constexpr size_t WS_HLOC = WS_GB + 5 * MiB;
constexpr size_t WS_CL = WS_HLOC + 65 * MiB;
constexpr size_t WS_ODN = WS_CL + 65 * MiB;
constexpr size_t WS_LAGG = WS_ODN + 65 * MiB;
constexpr size_t WS_MIX = WS_H;
constexpr size_t WS_DNB = WS_LAGG + 7 * MiB;
constexpr size_t WS_L0_END = WS_DNB + 230 * MiB;
constexpr size_t WS_HID = WS_S;
constexpr size_t WS_OGLA = WS_QN;
constexpr size_t WS_GLB = WS_OGLA + 128 * MiB;
constexpr size_t WS_GLZ = WS_GLB + 149 * MiB;
static_assert(WS_GLZ + 33 * MiB <= 1640 * MiB, "GLA blobs");
constexpr size_t WS_HID2 = WS_S;
constexpr size_t WS_XS = WS_S + 374 * MiB;
constexpr size_t WS_YB = WS_XS + 136 * MiB;
constexpr size_t WS_YBX = WS_YB + 136 * MiB;
constexpr size_t WS_END = WS_YBX + 64 * MiB;
static_assert(WS_L0_END <= 1640 * MiB && WS_END <= 1640 * MiB, "workspace map");
constexpr size_t SM_TOPI = 0;
constexpr size_t SM_TOPW = 128 * 1024;
constexpr size_t SM_POS = 256 * 1024;
constexpr size_t SM_SLOT = 384 * 1024;
constexpr size_t SM_WGBASE = 512 * 1024;
constexpr size_t SM_ROWMAP = 640 * 1024;
constexpr size_t SM_WVPRE = 800 * 1024;
constexpr size_t SM_WGCNT = 896 * 1024;
constexpr size_t SM_LRUW = 1024 * 1024;
constexpr int CW_CNT = 64;
constexpr int CW_BAR = 4096;

__device__ __forceinline__ float bf2f(unsigned b) { return __uint_as_float(b << 16); }
typedef __bf16 bf16v2_t __attribute__((ext_vector_type(2)));
__device__ __forceinline__ unsigned cvt_pk_bf16(float lo, float hi) { const f32x2 v = {lo, hi}; return __builtin_bit_cast(unsigned, __builtin_convertvector(v, bf16v2_t)); }
__device__ __forceinline__ unsigned short f2bf(float f) { return (unsigned short)(cvt_pk_bf16(f, 0.f) & 0xffffu); }
__device__ __forceinline__ void unpack8(const u32x4 w, float (&o)[8]) {
    o[0] = __uint_as_float(w.x << 16); o[1] = __uint_as_float(w.x & 0xffff0000u); o[2] = __uint_as_float(w.y << 16); o[3] = __uint_as_float(w.y & 0xffff0000u);
    o[4] = __uint_as_float(w.z << 16); o[5] = __uint_as_float(w.z & 0xffff0000u); o[6] = __uint_as_float(w.w << 16); o[7] = __uint_as_float(w.w & 0xffff0000u);
}
__device__ __forceinline__ u32x4 pack8(const float (&v)[8]) { u32x4 w; w.x = cvt_pk_bf16(v[0], v[1]); w.y = cvt_pk_bf16(v[2], v[3]); w.z = cvt_pk_bf16(v[4], v[5]); w.w = cvt_pk_bf16(v[6], v[7]); return w; }
__device__ __forceinline__ float fexp(float x) { return __builtin_amdgcn_exp2f(x * 1.4426950408889634f); }
__device__ __forceinline__ float flog(float x) { return __builtin_amdgcn_logf(x) * 0.6931471805599453f; }
__device__ __forceinline__ float frcp(float x) { return __builtin_amdgcn_rcpf(x); }
__device__ __forceinline__ float sigmoidf_(float x) { return frcp(1.0f + fexp(-x)); }
__device__ __forceinline__ float siluf_(float x) { return x * frcp(1.0f + fexp(-x)); }
__device__ __forceinline__ float softplusf_(float x) { return fmaxf(x, 0.f) + flog(1.0f + fexp(-fabsf(x))); }
__device__ __forceinline__ float gelu_tanh(float x) { const float u = 0.7978845608028654f * (x + 0.044715f * x * x * x); return x * frcp(1.0f + fexp(-2.0f * u)); }
__device__ __forceinline__ float wave_sum(float v) {
#pragma unroll
    for (int o = 1; o < 64; o <<= 1) v += __shfl_xor(v, o);
    return v;
}
__device__ __forceinline__ float sum16(float v) {
#pragma unroll
    for (int o = 1; o < 16; o <<= 1) v += __shfl_xor(v, o);
    return v;
}

namespace pg8 {
#define PG8_LAS __attribute__((address_space(3)))
typedef unsigned short bf16_t;
constexpr int BM = 256, BK = 64, HALF = 128, HTB = HALF * BK * 2, STAGE_BYTES = 8 * HTB, NXCD = 8, WGM = 8;
__host__ __device__ __forceinline__ int lds_byte(int r, int c) { const int st = (r >> 4) * 2 + (c >> 5), rr = r & 15, cc = c & 31, ob = rr * 64 + cc * 2; return st * 1024 + (ob ^ (((ob >> 9) & 1) << 5)); }
__host__ __device__ __forceinline__ void stage_rc(int b, int& R, int& C) { const int st = b / 1024, sb = b % 1024, swz = sb ^ (((sb >> 9) & 1) << 5); R = (st >> 1) * 16 + swz / 64; C = (st & 1) * 32 + (swz % 64) / 2; }
__host__ __device__ __forceinline__ int perm32(int rho) { const int n = rho >> 4, i = rho & 15; return 8 * (i >> 2) + 4 * n + (i & 3); }

struct Unit { int pm, pn, ko; };
struct Gemm { const bf16_t* A; const bf16_t* Bt; int M, N, K, ld; };

struct StaticOrder {
    int nM, nN, nwg, G, c;
    __host__ __device__ void init(int M, int N, int G_, int c_) { nM = M / BM; nN = N / BM; nwg = nM * nN; G = G_; c = c_; }
    __host__ __device__ bool next(int i, Unit& u) const {
        const long L = (long)i * G + c; if (L >= nwg) return false;
        int wgid = (int)L; { const int q = nwg / NXCD, r = nwg % NXCD, xcd = wgid % NXCD, off = wgid / NXCD; wgid = (xcd < r ? xcd * (q + 1) : r * (q + 1) + (xcd - r) * q) + off; }
        constexpr int WGS = 4;
        const int nig = WGS * nN, gid = wgid / nig, fm = gid * WGS, gsz = (nM - fm) < WGS ? (nM - fm) : WGS;
        u.pm = fm + ((wgid % nig) % gsz); u.pn = (wgid % nig) / gsz; u.ko = 0; return true;
    }
    __device__ __forceinline__ void a_ready(const Unit&) const {}
    __device__ __forceinline__ void done(const Unit&) const {}
};
struct MoeOrder {
    int nN, Mt, nwg, G, c; int tend[8];
    __device__ bool next(int i, Unit& u) const {
        const long L = (long)i * G + c; if (L >= nwg) return false;
        int wgid = (int)L; { const int q = nwg / NXCD, r = nwg % NXCD, xcd = wgid % NXCD, off = wgid / NXCD; wgid = (xcd < r ? xcd * (q + 1) : r * (q + 1) + (xcd - r) * q) + off; }
        const int nig = WGM * nN, gid = wgid / nig, fm = gid * WGM, gsz = (Mt - fm) < WGM ? (Mt - fm) : WGM;
        const int pm = fm + ((wgid % nig) % gsz), pnl = (wgid % nig) / gsz;
        int e = 0;
#pragma unroll
        for (int j = 0; j < 7; ++j) e += (pm >= tend[j]) ? 1 : 0;
        u.pm = pm; u.pn = e * nN + pnl; u.ko = 0; return true;
    }
    __device__ __forceinline__ void a_ready(const Unit&) const {}
    __device__ __forceinline__ void done(const Unit&) const {}
};

struct EpiProj {
    static constexpr bool PERM = true, AFTER_DRAIN = false;
    bf16_t* O; float* AUX; int ldc, npn;
    __device__ __forceinline__ void operator()(const f32x4 (&acc)[2][2][4][2], const Unit& u, int wr, int wc, int fr, int fq) const {
        const int row0 = u.pm * BM + wr * 64 + fr;
        if (u.pn < npn) {
            const int col0 = u.pn * BM + wc * 32 + 8 * fq;
#pragma unroll
            for (int ai = 0; ai < 2; ++ai)
#pragma unroll
                for (int m = 0; m < 4; ++m) { bf16_t* rowp = O + (size_t)(row0 + ai * HALF + m * 16) * ldc + col0;
#pragma unroll
                    for (int bj = 0; bj < 2; ++bj) { const f32x4 v0 = acc[ai][bj][m][0], v1 = acc[ai][bj][m][1];
                        u32x4 w; w.x = cvt_pk_bf16(v0[0], v0[1]); w.y = cvt_pk_bf16(v0[2], v0[3]); w.z = cvt_pk_bf16(v1[0], v1[1]); w.w = cvt_pk_bf16(v1[2], v1[3]);
                        *(u32x4*)(rowp + bj * HALF) = w; } }
        } else if (wc == 0) {
#pragma unroll
            for (int ai = 0; ai < 2; ++ai)
#pragma unroll
                for (int m = 0; m < 4; ++m) { float* rowp = AUX + (size_t)(row0 + ai * HALF + m * 16) * 32 + 8 * fq;
                    *(f32x4*)(rowp) = acc[ai][0][m][0]; *(f32x4*)(rowp + 4) = acc[ai][0][m][1]; }
        }
    }
};
struct EpiResid {
    static constexpr bool PERM = false, AFTER_DRAIN = false;
    float* X; const float* gate_lat; const float* gate_ctx; const float* base_lat; const float* base_ctx;
    __device__ __forceinline__ void operator()(const f32x4 (&acc)[2][2][4][2], const Unit& u, int wr, int wc, int fr, int fq) const {
        const float* gate = (u.pm >= 64) ? gate_ctx : gate_lat;
        const int row0 = u.pm * BM + wr * 64 + fr, col0 = u.pn * BM + wc * 32 + 4 * fq;
        const float* Bp = base_lat ? ((u.pm >= 64) ? base_ctx - (size_t)64 * BM * D : base_lat) : X;
        f32x4 gv[2][2];
#pragma unroll
        for (int bj = 0; bj < 2; ++bj)
#pragma unroll
            for (int n = 0; n < 2; ++n) gv[bj][n] = *(const f32x4*)(gate + col0 + bj * HALF + n * 16);
#pragma unroll
        for (int ai = 0; ai < 2; ++ai)
#pragma unroll
            for (int m = 0; m < 4; ++m) { const size_t ro = (size_t)(row0 + ai * HALF + m * 16) * D + col0;
#pragma unroll
                for (int bj = 0; bj < 2; ++bj)
#pragma unroll
                    for (int n = 0; n < 2; ++n) *(f32x4*)(X + ro + bj * HALF + n * 16) = *(const f32x4*)(Bp + ro + bj * HALF + n * 16) + gv[bj][n] * acc[ai][bj][m][n]; }
    }
};
struct EpiSwiglu {
    static constexpr bool PERM = true, AFTER_DRAIN = false;
    bf16_t* O; int ldc, nN;
    __device__ __forceinline__ void operator()(const f32x4 (&acc)[2][2][4][2], const Unit& u, int wr, int wc, int fr, int fq) const {
        const int pnl = u.pn % nN;
        const int row0 = u.pm * BM + wr * 64 + fr, col0 = pnl * HALF + wc * 32 + 8 * fq;
#pragma unroll
        for (int ai = 0; ai < 2; ++ai)
#pragma unroll
            for (int m = 0; m < 4; ++m) { bf16_t* rowp = O + (size_t)(row0 + ai * HALF + m * 16) * ldc + col0;
                float h[8];
#pragma unroll
                for (int n = 0; n < 2; ++n)
#pragma unroll
                    for (int j = 0; j < 4; ++j) { const float g = acc[ai][0][m][n][j], up = acc[ai][1][m][n][j]; h[4 * n + j] = g * frcp(1.0f + fexp(-g)) * up; }
                u32x4 w; w.x = cvt_pk_bf16(h[0], h[1]); w.y = cvt_pk_bf16(h[2], h[3]); w.z = cvt_pk_bf16(h[4], h[5]); w.w = cvt_pk_bf16(h[6], h[7]);
                *(u32x4*)(rowp) = w; }
    }
};
struct EpiBf16N {
    static constexpr bool PERM = true, AFTER_DRAIN = false;
    bf16_t* O; int ldc, nN;
    __device__ __forceinline__ void operator()(const f32x4 (&acc)[2][2][4][2], const Unit& u, int wr, int wc, int fr, int fq) const {
        const int pnl = u.pn % nN;
        const int row0 = u.pm * BM + wr * 64 + fr, col0 = pnl * BM + wc * 32 + 8 * fq;
#pragma unroll
        for (int ai = 0; ai < 2; ++ai)
#pragma unroll
            for (int m = 0; m < 4; ++m) { bf16_t* rowp = O + (size_t)(row0 + ai * HALF + m * 16) * ldc + col0;
#pragma unroll
                for (int bj = 0; bj < 2; ++bj) { const f32x4 v0 = acc[ai][bj][m][0], v1 = acc[ai][bj][m][1];
                    u32x4 w; w.x = cvt_pk_bf16(v0[0], v0[1]); w.y = cvt_pk_bf16(v0[2], v0[3]); w.z = cvt_pk_bf16(v1[0], v1[1]); w.w = cvt_pk_bf16(v1[2], v1[3]);
                    *(u32x4*)(rowp + bj * HALF) = w; } }
    }
};


struct MoeSplitOrder {
    int nN, tile0, Mt, KS, Ksub, nwg, G, c; int tend[8];
    __device__ bool next(int i, Unit& u) const {
        const long L = (long)i * G + c; if (L >= nwg) return false;
        const int l = (int)L, ks = l % KS, r = l / KS, pnl = r % nN, pm = tile0 + r / nN;
        int e = 0;
#pragma unroll
        for (int j = 0; j < 7; ++j) e += (pm >= tend[j]) ? 1 : 0;
        u.pm = pm; u.pn = e * nN + pnl; u.ko = ks * Ksub; return true;
    }
    __device__ __forceinline__ void a_ready(const Unit&) const {}
    __device__ __forceinline__ void done(const Unit&) const {}
};
struct EpiF32Part {
    static constexpr bool PERM = false, AFTER_DRAIN = false;
    float* P; int row0, rows, ldc, nN, Ksub;
    __device__ __forceinline__ void operator()(const f32x4 (&acc)[2][2][4][2], const Unit& u, int wr, int wc, int fr, int fq) const {
        const int pnl = u.pn % nN, ks = u.ko / Ksub;
        const int r0 = u.pm * BM - row0 + wr * 64 + fr, col0 = pnl * BM + wc * 32 + 4 * fq;
        float* base = P + (size_t)ks * rows * ldc;
#pragma unroll
        for (int ai = 0; ai < 2; ++ai)
#pragma unroll
            for (int m = 0; m < 4; ++m) { float* rowp = base + (size_t)(r0 + ai * HALF + m * 16) * ldc + col0;
#pragma unroll
                for (int bj = 0; bj < 2; ++bj)
#pragma unroll
                    for (int n = 0; n < 2; ++n) *(f32x4*)(rowp + bj * HALF + n * 16) = acc[ai][bj][m][n]; }
    }
};

template <class Epi, class Sched, bool ALIGN_EPI = false, bool SP2 = false>
__device__ __forceinline__ void gemm_phase(PG8_LAS unsigned char* lds, const Gemm g, const Sched& S, const Epi& E) {
    const int tid = threadIdx.x, wid = __builtin_amdgcn_readfirstlane(tid >> 6), lane = tid & 63, wr = wid >> 2, wc = wid & 3, fr = lane & 15, fq = lane >> 4;
    const int K = g.K, nt = K / BK, LD = g.ld;
    unsigned voffA[2], voffB[2];
#pragma unroll
    for (int i = 0; i < 2; ++i) { int R, C; stage_rc(tid * 16 + i * 8192, R, C); const int Rb = Epi::PERM ? ((R & ~31) + perm32(R & 31)) : R;
        voffA[i] = (unsigned)(R * LD + C) * 2u; voffB[i] = (unsigned)(Rb * LD + C) * 2u; }
    const size_t kstep = (size_t)(BK * 2);
    const size_t hstep = (size_t)HALF * LD * 2;
    const size_t tstep = 2 * hstep;
    const unsigned ldsw = (unsigned)wid * 1024u;
    const int aoff = lds_byte(wr * 64 + fr, fq * 8), boff = lds_byte(wc * 32 + fr, fq * 8);
#define PG8_SA(b, h) (((b) * 2 + (h)) * HTB)
#define PG8_SB(b, h) ((4 + (b) * 2 + (h)) * HTB)
#define PG8_STAGE(bufoff, gbase, voff) do { _Pragma("unroll") for (int _i = 0; _i < 2; ++_i) \
        __builtin_amdgcn_global_load_lds((const unsigned*)((const char*)(gbase) + (voff)[_i]), (PG8_LAS unsigned*)(lds + (bufoff) + ldsw + _i * 8192), 16, 0, 0); } while (0)
#define PG8_LDA(dst, b, h) do { _Pragma("unroll") for (int m = 0; m < 4; ++m) _Pragma("unroll") for (int k = 0; k < 2; ++k) dst[m][k] = *(const PG8_LAS bf16x8*)(lds + PG8_SA(b, h) + aoff + m * 2048 + k * 1024); } while (0)
#define PG8_LDB(dst, b, h) do { _Pragma("unroll") for (int n = 0; n < 2; ++n) _Pragma("unroll") for (int k = 0; k < 2; ++k) dst[n][k] = *(const PG8_LAS bf16x8*)(lds + PG8_SB(b, h) + boff + n * 2048 + k * 1024); } while (0)
#define PG8_MMA(ai, bj, At, Bt) do { __builtin_amdgcn_s_setprio(1); _Pragma("unroll") for (int m = 0; m < 4; ++m) _Pragma("unroll") for (int n = 0; n < 2; ++n) _Pragma("unroll") for (int k = 0; k < 2; ++k) \
        acc[ai][bj][m][n] = __builtin_amdgcn_mfma_f32_16x16x32_bf16(Bt[n][k], At[m][k], acc[ai][bj][m][n], 0, 0, 0); __builtin_amdgcn_s_setprio(0); } while (0)
#define PG8_WAIT_V(n) asm volatile("s_waitcnt vmcnt(" #n ")" ::: "memory")
#define PG8_WAIT_L(n) asm volatile("s_waitcnt lgkmcnt(" #n ")" ::: "memory")
#define PG8_BAR __builtin_amdgcn_s_barrier()
#define PG8_SCHED __builtin_amdgcn_sched_barrier(0)
    Unit cur, nxt; int ui = 0;
    if (!S.next(0, cur)) return;
    f32x4 acc[2][2][4][2];
#pragma unroll
    for (int a = 0; a < 2; ++a)
#pragma unroll
        for (int b = 0; b < 2; ++b)
#pragma unroll
            for (int m = 0; m < 4; ++m)
#pragma unroll
                for (int n = 0; n < 2; ++n) acc[a][b][m][n] = (f32x4){0.f, 0.f, 0.f, 0.f};
    bf16x8 At[4][2], B0[2][2], B1[2][2];
    const char* cA = (const char*)g.A + (size_t)cur.pm * tstep + (size_t)cur.ko * 2; const char* cB = (const char*)g.Bt + (size_t)cur.pn * tstep + (size_t)cur.ko * 2;
    S.a_ready(cur);
    if constexpr (SP2) {
        PG8_STAGE(PG8_SB(0, 0), cB, voffB); PG8_STAGE(PG8_SB(0, 1), cB + hstep, voffB); PG8_STAGE(PG8_SA(0, 0), cA, voffA); PG8_STAGE(PG8_SA(0, 1), cA + hstep, voffA);
        if (wr == 1) PG8_BAR;
        PG8_WAIT_V(2); PG8_BAR;
        PG8_STAGE(PG8_SB(1, 0), cB + kstep, voffB); PG8_STAGE(PG8_SA(1, 0), cA + kstep, voffA); PG8_STAGE(PG8_SB(1, 1), cB + hstep + kstep, voffB);
        PG8_WAIT_V(6); PG8_BAR;
    } else {
        PG8_STAGE(PG8_SB(0, 0), cB, voffB); PG8_STAGE(PG8_SA(0, 0), cA, voffA); PG8_STAGE(PG8_SB(0, 1), cB + hstep, voffB); PG8_STAGE(PG8_SA(0, 1), cA + hstep, voffA);
        if (wr == 1) PG8_BAR;
        PG8_WAIT_V(4); PG8_BAR;
        PG8_STAGE(PG8_SB(1, 0), cB + kstep, voffB); PG8_STAGE(PG8_SA(1, 0), cA + kstep, voffA); PG8_STAGE(PG8_SB(1, 1), cB + hstep + kstep, voffB);
        PG8_WAIT_V(6); PG8_BAR;
    }
    for (;;) {
        const bool has_next = S.next(ui + 1, nxt);
        const char* nA = has_next ? (const char*)g.A + (size_t)nxt.pm * tstep + (size_t)nxt.ko * 2 : cA; const char* nB = has_next ? (const char*)g.Bt + (size_t)nxt.pn * tstep + (size_t)nxt.ko * 2 : cB;
        for (int t = 0; t < nt; t += 2) {
            const bool last = (t == nt - 2);
            const char* a1 = cA + (size_t)(t + 1) * kstep;
            const char* a2 = last ? nA : cA + (size_t)(t + 2) * kstep; const char* b2 = last ? nB : cB + (size_t)(t + 2) * kstep;
            const char* a3 = a2 + kstep; const char* b3 = b2 + kstep;
            if (last && has_next) S.a_ready(nxt);
            if constexpr (SP2) {
            PG8_LDB(B0, 0, 0); PG8_LDB(B1, 0, 1); PG8_SCHED; PG8_LDA(At, 0, 0); PG8_STAGE(PG8_SA(1, 1), a1 + hstep, voffA);
            PG8_WAIT_V(8); PG8_WAIT_L(0); PG8_BAR; PG8_MMA(0, 0, At, B0); PG8_MMA(0, 1, At, B1); PG8_BAR; PG8_SCHED;
            PG8_LDA(At, 0, 1); PG8_STAGE(PG8_SB(0, 0), b2, voffB); PG8_STAGE(PG8_SB(0, 1), b2 + hstep, voffB); PG8_STAGE(PG8_SA(0, 0), a2, voffA);
            PG8_WAIT_V(8); PG8_WAIT_L(0); PG8_BAR; PG8_MMA(1, 0, At, B0); PG8_MMA(1, 1, At, B1); PG8_BAR; PG8_SCHED;
            PG8_LDB(B0, 1, 0); PG8_LDB(B1, 1, 1); PG8_SCHED; PG8_LDA(At, 1, 0); PG8_STAGE(PG8_SA(0, 1), a2 + hstep, voffA);
            PG8_WAIT_V(8); PG8_WAIT_L(0); PG8_BAR; PG8_MMA(0, 0, At, B0); PG8_MMA(0, 1, At, B1); PG8_BAR; PG8_SCHED;
            PG8_LDA(At, 1, 1); PG8_STAGE(PG8_SB(1, 0), b3, voffB); PG8_STAGE(PG8_SB(1, 1), b3 + hstep, voffB); PG8_STAGE(PG8_SA(1, 0), a3, voffA);
            PG8_WAIT_V(8); PG8_WAIT_L(0); PG8_BAR; PG8_MMA(1, 0, At, B0); PG8_MMA(1, 1, At, B1); PG8_BAR; PG8_SCHED;
            } else {
            PG8_LDB(B0, 0, 0); PG8_SCHED; PG8_LDA(At, 0, 0); PG8_STAGE(PG8_SA(1, 1), a1 + hstep, voffA);
            PG8_WAIT_L(8); PG8_BAR; PG8_WAIT_L(0); PG8_MMA(0, 0, At, B0); PG8_BAR; PG8_SCHED;
            PG8_LDB(B1, 0, 1); PG8_STAGE(PG8_SB(0, 0), b2, voffB);
            PG8_BAR; PG8_WAIT_L(0); PG8_MMA(0, 1, At, B1); PG8_BAR;
            PG8_LDA(At, 0, 1); PG8_STAGE(PG8_SA(0, 0), a2, voffA);
            PG8_BAR; PG8_WAIT_L(0); PG8_MMA(1, 0, At, B0); PG8_BAR; PG8_SCHED;
            PG8_STAGE(PG8_SB(0, 1), b2 + hstep, voffB);
            PG8_WAIT_V(6); PG8_BAR; PG8_MMA(1, 1, At, B1); PG8_BAR;
            PG8_LDB(B0, 1, 0); PG8_SCHED; PG8_LDA(At, 1, 0); PG8_STAGE(PG8_SA(0, 1), a2 + hstep, voffA);
            PG8_WAIT_L(8); PG8_BAR; PG8_WAIT_L(0); PG8_MMA(0, 0, At, B0); PG8_BAR; PG8_SCHED;
            PG8_LDB(B1, 1, 1); PG8_STAGE(PG8_SB(1, 0), b3, voffB);
            PG8_BAR; PG8_WAIT_L(0); PG8_MMA(0, 1, At, B1); PG8_BAR;
            PG8_LDA(At, 1, 1); PG8_STAGE(PG8_SA(1, 0), a3, voffA);
            PG8_BAR; PG8_WAIT_L(0); PG8_MMA(1, 0, At, B0); PG8_BAR; PG8_SCHED;
            PG8_STAGE(PG8_SB(1, 1), b3 + hstep, voffB);
            PG8_WAIT_V(6); PG8_BAR; PG8_MMA(1, 1, At, B1); PG8_BAR;
            }
        }
        if constexpr (ALIGN_EPI) { if (wr == 0) PG8_BAR; }
        if constexpr (!Epi::AFTER_DRAIN) { E(acc, cur, wr, wc, fr, fq); S.done(cur); }
        if (!has_next) break;
#pragma unroll
        for (int a = 0; a < 2; ++a)
#pragma unroll
            for (int b = 0; b < 2; ++b)
#pragma unroll
                for (int m = 0; m < 4; ++m)
#pragma unroll
                    for (int n = 0; n < 2; ++n) acc[a][b][m][n] = (f32x4){0.f, 0.f, 0.f, 0.f};
        cur = nxt; cA = nA; cB = nB; ++ui;
        if constexpr (ALIGN_EPI) { if (wr == 1) PG8_BAR; }
    }
    PG8_WAIT_V(0);
    if constexpr (!ALIGN_EPI) { if (wr == 0) PG8_BAR; }
    PG8_BAR;
#undef PG8_SA
#undef PG8_SB
#undef PG8_STAGE
#undef PG8_LDA
#undef PG8_LDB
#undef PG8_MMA
#undef PG8_WAIT_V
#undef PG8_WAIT_L
#undef PG8_BAR
#undef PG8_SCHED
}

template <class Epi, class Sched>
__device__ __forceinline__ void gemm_phase_gather(PG8_LAS unsigned char* lds, const Gemm g, const int* rowmap, const Sched& S, const Epi& E) {
    const int tid = threadIdx.x, wid = __builtin_amdgcn_readfirstlane(tid >> 6), lane = tid & 63, wr = wid >> 2, wc = wid & 3, fr = lane & 15, fq = lane >> 4;
    const int K = g.K, nt = K / BK, LD = g.ld;
    unsigned voffB[2];
#pragma unroll
    for (int i = 0; i < 2; ++i) { int R, C; stage_rc(tid * 16 + i * 8192, R, C); const int Rb = Epi::PERM ? ((R & ~31) + perm32(R & 31)) : R;
        voffB[i] = (unsigned)(Rb * LD + C) * 2u; }
    const size_t kstep = (size_t)(BK * 2);
    const size_t hstep = (size_t)HALF * LD * 2;
    const size_t tstep = 2 * hstep;
    const unsigned ldsw = (unsigned)wid * 1024u;
    const int aoff = lds_byte(wr * 64 + fr, fq * 8), boff = lds_byte(wc * 32 + fr, fq * 8);
#define PG8_SA(b, h) (((b) * 2 + (h)) * HTB)
#define PG8_SB(b, h) ((4 + (b) * 2 + (h)) * HTB)
#define PG8_STAGE(bufoff, gbase, voff) do { _Pragma("unroll") for (int _i = 0; _i < 2; ++_i) \
        __builtin_amdgcn_global_load_lds((const unsigned*)((const char*)(gbase) + (voff)[_i]), (PG8_LAS unsigned*)(lds + (bufoff) + ldsw + _i * 8192), 16, 0, 0); } while (0)
#define PG8_LDA(dst, b, h) do { _Pragma("unroll") for (int m = 0; m < 4; ++m) _Pragma("unroll") for (int k = 0; k < 2; ++k) dst[m][k] = *(const PG8_LAS bf16x8*)(lds + PG8_SA(b, h) + aoff + m * 2048 + k * 1024); } while (0)
#define PG8_LDB(dst, b, h) do { _Pragma("unroll") for (int n = 0; n < 2; ++n) _Pragma("unroll") for (int k = 0; k < 2; ++k) dst[n][k] = *(const PG8_LAS bf16x8*)(lds + PG8_SB(b, h) + boff + n * 2048 + k * 1024); } while (0)
#define PG8_MMA(ai, bj, At, Bt) do { __builtin_amdgcn_s_setprio(1); _Pragma("unroll") for (int m = 0; m < 4; ++m) _Pragma("unroll") for (int n = 0; n < 2; ++n) _Pragma("unroll") for (int k = 0; k < 2; ++k) \
        acc[ai][bj][m][n] = __builtin_amdgcn_mfma_f32_16x16x32_bf16(Bt[n][k], At[m][k], acc[ai][bj][m][n], 0, 0, 0); __builtin_amdgcn_s_setprio(0); } while (0)
#define PG8_WAIT_V(n) asm volatile("s_waitcnt vmcnt(" #n ")" ::: "memory")
#define PG8_WAIT_L(n) asm volatile("s_waitcnt lgkmcnt(" #n ")" ::: "memory")
#define PG8_BAR __builtin_amdgcn_s_barrier()
#define PG8_SCHED __builtin_amdgcn_sched_barrier(0)
#define PG8_ROWOFFS(V, pm_) do { _Pragma("unroll") for (int i_ = 0; i_ < 2; ++i_) { int R_, C_; stage_rc(threadIdx.x * 16 + i_ * 8192, R_, C_); \
        _Pragma("unroll") for (int h_ = 0; h_ < 2; ++h_) V[h_][i_] = (unsigned)rowmap[(pm_) * BM + h_ * HALF + R_] * (unsigned)(LD * 2) + (unsigned)C_ * 2u; } } while (0)
    Unit cur, nxt; int ui = 0;
    if (!S.next(0, cur)) return;
    f32x4 acc[2][2][4][2];
#pragma unroll
    for (int a = 0; a < 2; ++a)
#pragma unroll
        for (int b = 0; b < 2; ++b)
#pragma unroll
            for (int m = 0; m < 4; ++m)
#pragma unroll
                for (int n = 0; n < 2; ++n) acc[a][b][m][n] = (f32x4){0.f, 0.f, 0.f, 0.f};
    bf16x8 At[4][2], B0[2][2], B1[2][2];
    const char* gA = (const char*)g.A; const char* cB = (const char*)g.Bt + (size_t)cur.pn * tstep;
    unsigned vA[2][2], vN[2][2];
    PG8_ROWOFFS(vA, cur.pm);
    PG8_STAGE(PG8_SB(0, 0), cB, voffB); PG8_STAGE(PG8_SB(0, 1), cB + hstep, voffB); PG8_STAGE(PG8_SA(0, 0), gA, vA[0]); PG8_STAGE(PG8_SA(0, 1), gA, vA[1]);
    if (wr == 1) PG8_BAR;
    PG8_WAIT_V(2); PG8_BAR;
    PG8_STAGE(PG8_SB(1, 0), cB + kstep, voffB); PG8_STAGE(PG8_SA(1, 0), gA + kstep, vA[0]); PG8_STAGE(PG8_SB(1, 1), cB + hstep + kstep, voffB);
    PG8_WAIT_V(6); PG8_BAR;
    for (;;) {
        const bool has_next = S.next(ui + 1, nxt);
        const char* nB = has_next ? (const char*)g.Bt + (size_t)nxt.pn * tstep : cB;
        if (has_next) PG8_ROWOFFS(vN, nxt.pm);
        else {
#pragma unroll
            for (int h_ = 0; h_ < 2; ++h_) { vN[h_][0] = vA[h_][0]; vN[h_][1] = vA[h_][1]; } }
        for (int t = 0; t < nt; t += 2) {
            const bool last = (t == nt - 2);
            const char* a1 = gA + (size_t)(t + 1) * kstep;
            const char* a2 = last ? gA : gA + (size_t)(t + 2) * kstep; const char* b2 = last ? nB : cB + (size_t)(t + 2) * kstep;
            const char* a3 = a2 + kstep; const char* b3 = b2 + kstep;
            unsigned v2[2][2];
#pragma unroll
            for (int h_ = 0; h_ < 2; ++h_) { v2[h_][0] = last ? vN[h_][0] : vA[h_][0]; v2[h_][1] = last ? vN[h_][1] : vA[h_][1]; }
            PG8_LDB(B0, 0, 0); PG8_LDB(B1, 0, 1); PG8_SCHED; PG8_LDA(At, 0, 0); PG8_STAGE(PG8_SA(1, 1), a1, vA[1]);
            PG8_WAIT_V(8); PG8_WAIT_L(0); PG8_BAR; PG8_MMA(0, 0, At, B0); PG8_MMA(0, 1, At, B1); PG8_BAR; PG8_SCHED;
            PG8_LDA(At, 0, 1); PG8_STAGE(PG8_SB(0, 0), b2, voffB); PG8_STAGE(PG8_SB(0, 1), b2 + hstep, voffB); PG8_STAGE(PG8_SA(0, 0), a2, v2[0]);
            PG8_WAIT_V(8); PG8_WAIT_L(0); PG8_BAR; PG8_MMA(1, 0, At, B0); PG8_MMA(1, 1, At, B1); PG8_BAR; PG8_SCHED;
            PG8_LDB(B0, 1, 0); PG8_LDB(B1, 1, 1); PG8_SCHED; PG8_LDA(At, 1, 0); PG8_STAGE(PG8_SA(0, 1), a2, v2[1]);
            PG8_WAIT_V(8); PG8_WAIT_L(0); PG8_BAR; PG8_MMA(0, 0, At, B0); PG8_MMA(0, 1, At, B1); PG8_BAR; PG8_SCHED;
            PG8_LDA(At, 1, 1); PG8_STAGE(PG8_SB(1, 0), b3, voffB); PG8_STAGE(PG8_SB(1, 1), b3 + hstep, voffB); PG8_STAGE(PG8_SA(1, 0), a3, v2[0]);
            PG8_WAIT_V(8); PG8_WAIT_L(0); PG8_BAR; PG8_MMA(1, 0, At, B0); PG8_MMA(1, 1, At, B1); PG8_BAR; PG8_SCHED;
        }
        if (wr == 0) PG8_BAR;
        E(acc, cur, wr, wc, fr, fq);
        if (!has_next) break;
#pragma unroll
        for (int a = 0; a < 2; ++a)
#pragma unroll
            for (int b = 0; b < 2; ++b)
#pragma unroll
                for (int m = 0; m < 4; ++m)
#pragma unroll
                    for (int n = 0; n < 2; ++n) acc[a][b][m][n] = (f32x4){0.f, 0.f, 0.f, 0.f};
        cur = nxt; cB = nB; ++ui;
#pragma unroll
        for (int h_ = 0; h_ < 2; ++h_) { vA[h_][0] = vN[h_][0]; vA[h_][1] = vN[h_][1]; }
        if (wr == 1) PG8_BAR;
    }
    PG8_WAIT_V(0);
    PG8_BAR;
#undef PG8_SA
#undef PG8_SB
#undef PG8_STAGE
#undef PG8_LDA
#undef PG8_LDB
#undef PG8_MMA
#undef PG8_WAIT_V
#undef PG8_WAIT_L
#undef PG8_BAR
#undef PG8_SCHED
#undef PG8_ROWOFFS
}
}

#define XB_TMO      128
#define XB_XCNT(j)  (256  + 64 * (j))
#define XB_XSUB(j)  (1280 + 64 * (j))
#define XB_XGEN(j)  (2304 + 64 * (j))
#define XB_TOP      3328
#define XB_TOPGEN   3392
#define XCD_BAR_WORDS 3456
#define XB_SPIN_CAP (1u << 21)
__device__ __forceinline__ unsigned xb_ld(unsigned* p)              { return __hip_atomic_load(p, __ATOMIC_RELAXED, __HIP_MEMORY_SCOPE_AGENT); }
__device__ __forceinline__ unsigned xb_add(unsigned* p, unsigned v) { return __hip_atomic_fetch_add(p, v, __ATOMIC_RELAXED, __HIP_MEMORY_SCOPE_AGENT); }
__device__ __forceinline__ unsigned xb_xcc_id() { return (unsigned)__builtin_amdgcn_s_getreg((3 << 11) | 20) & 0xFu; }
#define XB_SPIN(cond, bar) do { unsigned _sp = 0; while (cond) { __builtin_amdgcn_s_sleep(1); \
    if ((++_sp & 255u) == 0u) { if (xb_ld(&(bar)[XB_TMO])) break; if (_sp > XB_SPIN_CAP) { atomicAdd(&(bar)[XB_TMO], 1u); break; } } } } while (0)
struct XcdBarrier { unsigned* bar; unsigned x; volatile LAS unsigned* st; };
__device__ __forceinline__ XcdBarrier xcd_barrier_post(unsigned* bar, volatile LAS unsigned* st) {
    XcdBarrier b; b.bar = bar; b.x = xb_xcc_id(); b.st = st;
    if (threadIdx.x == 0) (void)xb_add(&bar[XB_XCNT(b.x)], 1u);
    return b;
}
__device__ __forceinline__ void xcd_barrier_complete(unsigned* bar, unsigned x, unsigned& nloc, unsigned& nx) {
    const unsigned G = gridDim.x * gridDim.y * gridDim.z;
    unsigned sum, cnt, mine, sp = 0u;
    for (;;) {
        sum = 0u; cnt = 0u; mine = 0u;
#pragma unroll
        for (unsigned j = 0; j < 16; ++j) { const unsigned c = xb_ld(&bar[XB_XCNT(j)]); sum += c; cnt += (c > 0u) ? 1u : 0u; mine = (j == x) ? c : mine; }
        if (sum == G) break;
        __builtin_amdgcn_s_sleep(1);
        if ((++sp & 255u) == 0u) { if (xb_ld(&bar[XB_TMO])) break; if (sp > XB_SPIN_CAP) { atomicAdd(&bar[XB_TMO], 1u); break; } }
    }
    nloc = mine > 0u ? mine : 1u; nx = cnt > 0u ? cnt : 1u;
}
__device__ __forceinline__ void xcd_barrier(const XcdBarrier& b) {
    asm volatile("s_waitcnt vmcnt(0)" ::: "memory");
    __syncthreads();
    if (threadIdx.x == 0) {
        unsigned* bar = b.bar;
        __builtin_amdgcn_s_waitcnt(0);
        unsigned nloc = b.st[0], nx = b.st[1];
        if (nloc == 0u) { xcd_barrier_complete(bar, b.x, nloc, nx); b.st[0] = nloc; b.st[1] = nx; }
        const unsigned old = xb_add(&bar[XB_XSUB(b.x)], 1u);
        const unsigned gen = old / nloc;
        if (old + 1u == (gen + 1u) * nloc) {
            __builtin_amdgcn_fence(__ATOMIC_RELEASE, "agent");
            asm volatile("s_waitcnt vmcnt(0)" ::: "memory");
            const unsigned og = xb_add(&bar[XB_TOP], 1u);
            const unsigned tg = og / nx;
            if (og + 1u == (tg + 1u) * nx) xb_add(&bar[XB_TOPGEN], 1u);
            else XB_SPIN(xb_ld(&bar[XB_TOPGEN]) == tg, bar);
            __builtin_amdgcn_fence(__ATOMIC_ACQUIRE, "agent");
            xb_add(&bar[XB_XGEN(b.x)], 1u);
            asm volatile("s_waitcnt vmcnt(0)" ::: "memory");
        } else {
            XB_SPIN(xb_ld(&bar[XB_XGEN(b.x)]) == gen, bar);
            __builtin_amdgcn_fence(__ATOMIC_ACQUIRE, "agent");
            asm volatile("s_waitcnt vmcnt(0)" ::: "memory");
        }
    }
    __syncthreads();
}

constexpr int NWAVES = 8, NTHREADS = 512;
constexpr int RING_BYTES = 155648;
constexpr int LDSCTL_OFF = RING_BYTES;
constexpr int LDS_BYTES = 163840;
enum { IN_X = 0, IN_C, IN_CTX, IN_CCTX, IN_MODW, IN_MODB, IN_N1G, IN_N2G, IN_EVWIN, IN_EVCONV, IN_ALOG, IN_DTB, IN_DNG, IN_LCW, IN_LCB, IN_LWA, IN_LBA, IN_LWX, IN_LBX, IN_LAM,
       IN_EVWOUT, IN_EVGATE, IN_EVUP, IN_EVDOWN, IN_ODWIN, IN_WG2, IN_BG, IN_GLAG, IN_ODWOUT, IN_RW, IN_RB, IN_XGATE, IN_XUP, IN_XDOWN, IN_FNG, N_IN };
struct Args { const float* in[N_IN]; float* out; unsigned char* ws; int ph_lo, ph_hi; };
constexpr int N_PHASES = 21;

__device__ __forceinline__ void p0_adaln(const Args& a, LAS unsigned char* lds, int tid, int layer, int wg, int nwg) {
    LAS float* s0 = (LAS float*)lds; LAS float* s1 = s0 + D; LAS float* red = s1 + D;
    for (int i = tid; i < D; i += NTHREADS) { s0[i] = siluf_(a.in[IN_C][i]); s1[i] = siluf_(a.in[IN_CCTX][i]); }
    __syncthreads();
    float* MOD = (float*)(a.ws + WS_MOD);
    const int cl = tid & 15, kg = tid >> 4;
    for (int cb = wg; cb < 192; cb += nwg) {
        const int col = cb * 64 + cl * 4;
        const float* W = a.in[IN_MODW] + (size_t)layer * D * (6 * D) + col;
        f32x4 a0 = {0.f, 0.f, 0.f, 0.f}, a1 = {0.f, 0.f, 0.f, 0.f};
#pragma unroll 8
        for (int kk = 0; kk < 64; ++kk) { const int k = kg * 64 + kk; const f32x4 w = *(const f32x4*)(W + (size_t)k * (6 * D)); a0 += w * s0[k]; a1 += w * s1[k]; }
        LAS float* r = red + (kg * 16 + cl) * 8;
        r[0] = a0[0]; r[1] = a0[1]; r[2] = a0[2]; r[3] = a0[3]; r[4] = a1[0]; r[5] = a1[1]; r[6] = a1[2]; r[7] = a1[3];
        __syncthreads();
        if (tid < 128) {
            const int cond = tid >> 6, c = tid & 63; float s = 0.f;
#pragma unroll
            for (int g = 0; g < 32; ++g) s += red[(g * 16 + (c >> 2)) * 8 + cond * 4 + (c & 3)];
            const int n = cb * 64 + c;
            MOD[((size_t)layer * 2 + cond) * (6 * D) + n] = s + a.in[IN_MODB][layer * 6 * D + n];
        }
        __syncthreads();
    }
}
template <int MAP> __device__ __forceinline__ int map_row(int n0) {
    if (MAP == 0) return n0;
    if (MAP == 1) return 256 * (n0 / 128) + (n0 % 128);
    if (MAP == 2) return 256 * (n0 / 128) + 128 + (n0 % 128);
    return n0 < 4096 ? n0 : (n0 < 4128 ? 6144 + (n0 - 4096) : n0 - 32);
}
template <int MAP> __device__ __forceinline__ void transpose_job(const float* W, int K, int N, bf16* WT, LAS float* scr, int gw, int ngw, int lane) {
    const int nblk = N / 32, nitems = (K / 64) * nblk;
    float cur[32], nxt[32];
#define TJ_LOAD(R, item_) do { const int kb_ = (item_) / nblk, nb_ = (item_) % nblk; const float* src_ = W + (size_t)(64 * kb_ + (lane >> 5)) * N + 32 * nb_ + (lane & 31); \
        _Pragma("unroll") for (int i = 0; i < 32; ++i) R[i] = src_[(size_t)(2 * i) * N]; } while (0)
    int item = gw;
    if (item < nitems) TJ_LOAD(cur, item);
    while (item < nitems) {
        const int nitem = item + ngw;
        if (nitem < nitems) TJ_LOAD(nxt, nitem);
        const int kb = item / nblk, nb = item % nblk, k0 = 64 * kb, n0 = 32 * nb;
#pragma unroll
        for (int i = 0; i < 32; ++i) scr[(2 * i + (lane >> 5)) * 33 + (lane & 31)] = cur[i];
        asm volatile("s_waitcnt lgkmcnt(0)" ::: "memory");
        const int c = lane & 7; const int r0 = map_row<MAP>(n0);
#pragma unroll
        for (int j = 0; j < 4; ++j) { const int n = (lane >> 3) + 8 * j; const LAS float* sp = scr + (8 * c) * 33 + n;
            u32x4 o; o.x = cvt_pk_bf16(sp[0 * 33], sp[1 * 33]); o.y = cvt_pk_bf16(sp[2 * 33], sp[3 * 33]); o.z = cvt_pk_bf16(sp[4 * 33], sp[5 * 33]); o.w = cvt_pk_bf16(sp[6 * 33], sp[7 * 33]);
            *(u32x4*)(WT + (size_t)(r0 + n) * K + k0 + 8 * c) = o; }
        asm volatile("s_waitcnt lgkmcnt(0)" ::: "memory");
#pragma unroll
        for (int i = 0; i < 32; ++i) cur[i] = nxt[i];
        item = nitem;
    }
#undef TJ_LOAD
}


constexpr int XITEMS_PER_JOB = 5632, XITEMS = 24 * XITEMS_PER_JOB;
__device__ __forceinline__ void expert_convert_range(const Args& a, LAS float* scr, int gi0, int gi1, int gw, int ngw, int lane) {
    float cur[32], nxt[32];
#define XJ_SETUP(gi_, W_, N_, nblk_, li_) const int job_##gi_ = (gi_) / XITEMS_PER_JOB, li_ = (gi_) % XITEMS_PER_JOB, e_##gi_ = job_##gi_ / 3, mat_##gi_ = job_##gi_ % 3; \
        const int N_ = mat_##gi_ == 2 ? D : FF, nblk_ = N_ / 32; \
        const float* W_ = (mat_##gi_ == 0 ? a.in[IN_XGATE] : (mat_##gi_ == 1 ? a.in[IN_XUP] : a.in[IN_XDOWN])) + (size_t)e_##gi_ * D * FF;
#define XJ_LOAD(R, W_, N_, nblk_, li_) do { const int kb_ = (li_) / (nblk_), nb_ = (li_) % (nblk_); const float* src_ = (W_) + (size_t)(64 * kb_ + (lane >> 5)) * (N_) + 32 * nb_ + (lane & 31); \
        _Pragma("unroll") for (int i = 0; i < 32; ++i) R[i] = src_[(size_t)(2 * i) * (N_)]; } while (0)
    int gi = gi0 + gw;
    if (gi < gi1) { XJ_SETUP(gi, W0, N0, nb0, li0) XJ_LOAD(cur, W0, N0, nb0, li0); }
    while (gi < gi1) {
        const int gn = gi + ngw;
        if (gn < gi1) { XJ_SETUP(gn, W1, N1, nb1, li1) XJ_LOAD(nxt, W1, N1, nb1, li1); }
        const int job = gi / XITEMS_PER_JOB, li = gi % XITEMS_PER_JOB, e = job / 3, mat = job % 3;
        const int N = mat == 2 ? D : FF, K = mat == 2 ? FF : D, nblk = N / 32, kb = li / nblk, nb = li % nblk, k0 = 64 * kb, n0 = 32 * nb;
        bf16* WT = mat == 2 ? (bf16*)(a.ws + WS_W_XDN) + (size_t)e * D * FF : (bf16*)(a.ws + WS_W_XGU) + (size_t)e * 2 * FF * D;
        const int r0 = mat == 2 ? n0 : 256 * (n0 / 128) + (n0 % 128) + (mat == 1 ? 128 : 0);
#pragma unroll
        for (int i = 0; i < 32; ++i) scr[(2 * i + (lane >> 5)) * 33 + (lane & 31)] = cur[i];
        asm volatile("s_waitcnt lgkmcnt(0)" ::: "memory");
        const int c = lane & 7;
#pragma unroll
        for (int j = 0; j < 4; ++j) { const int n = (lane >> 3) + 8 * j; const LAS float* sp = scr + (8 * c) * 33 + n;
            u32x4 o; o.x = cvt_pk_bf16(sp[0 * 33], sp[1 * 33]); o.y = cvt_pk_bf16(sp[2 * 33], sp[3 * 33]); o.z = cvt_pk_bf16(sp[4 * 33], sp[5 * 33]); o.w = cvt_pk_bf16(sp[6 * 33], sp[7 * 33]);
            *(u32x4*)(WT + (size_t)(r0 + n) * K + k0 + 8 * c) = o; }
        asm volatile("s_waitcnt lgkmcnt(0)" ::: "memory");
#pragma unroll
        for (int i = 0; i < 32; ++i) cur[i] = nxt[i];
        gi = gn;
    }
#undef XJ_SETUP
#undef XJ_LOAD
}
constexpr int XC_GW2 = 233, XC_GW7 = 176, XC_GW9 = 240, XC_GW10 = 176;
constexpr int XC_B0 = 0, XC_B1 = 15000, XC_B2 = 39000, XC_B3 = 54000, XC_B4 = 120000, XC_B5 = XITEMS;
constexpr int XC_GW12 = 233;

__device__ __forceinline__ void norm_row(const float* src, const float* g, const float* sh, const float* sc, bf16* dst, float* copy_dst, int lane, f32x4 (&h)[8]) {
    f32x4 v[8]; float ss = 0.f;
#pragma unroll
    for (int j = 0; j < 8; ++j) { v[j] = *(const f32x4*)(src + 4 * lane + 256 * j); ss += (v[j][0] * v[j][0] + v[j][1] * v[j][1]) + (v[j][2] * v[j][2] + v[j][3] * v[j][3]); }
    if (copy_dst) {
#pragma unroll
        for (int j = 0; j < 8; ++j) *(f32x4*)(copy_dst + 4 * lane + 256 * j) = v[j];
    }
    const float rstd = 1.0f / sqrtf(wave_sum(ss) * (1.0f / D) + EPS);
#pragma unroll
    for (int j = 0; j < 8; ++j) { const int c = 4 * lane + 256 * j; const f32x4 gg = *(const f32x4*)(g + c), s1 = *(const f32x4*)(sc + c), s0 = *(const f32x4*)(sh + c);
        h[j] = (v[j] * rstd * gg) * (1.0f + s1) + s0;
        u32x2 w; w.x = cvt_pk_bf16(h[j][0], h[j][1]); w.y = cvt_pk_bf16(h[j][2], h[j][3]); *(u32x2*)(dst + c) = w; }
}

__device__ __forceinline__ void norm_stage_ab(LAS float* A, LAS float* B, const float* g, const float* sh, const float* sc, int tid) {
    for (int i = tid; i < D; i += NTHREADS) { A[i] = g[i] * (1.0f + sc[i]); B[i] = sh[i]; }
}
__device__ __forceinline__ void norm_row_ab(const float* src, const LAS float* A, const LAS float* B, bf16* dst, int lane, f32x4 (&h)[8]) {
    f32x4 v[8]; float ss = 0.f;
#pragma unroll
    for (int j = 0; j < 8; ++j) { v[j] = *(const f32x4*)(src + 4 * lane + 256 * j); ss += (v[j][0] * v[j][0] + v[j][1] * v[j][1]) + (v[j][2] * v[j][2] + v[j][3] * v[j][3]); }
    const float rstd = 1.0f / sqrtf(wave_sum(ss) * (1.0f / D) + EPS);
#pragma unroll
    for (int j = 0; j < 8; ++j) { const int c = 4 * lane + 256 * j;
        h[j] = (v[j] * rstd) * *(const LAS f32x4*)(A + c) + *(const LAS f32x4*)(B + c);
        u32x2 w; w.x = cvt_pk_bf16(h[j][0], h[j][1]); w.y = cvt_pk_bf16(h[j][2], h[j][3]); *(u32x2*)(dst + c) = w; }
}
__device__ __forceinline__ void ev_prep_load(const Args& a, int r, int qt, int lane, u32x4 (&x)[2][4]) {
    const bf16* PROJ = (const bf16*)(a.ws + WS_PROJ); const int lo = r < T ? 0 : T, hi = r < T ? T : MT;
#pragma unroll
    for (int t = 0; t < 2; ++t) { const int col = qt < 3 ? ((2 * qt + t) * 64 + lane) * 8 : 4096 + (t * 64 + lane) * 8;
#pragma unroll
        for (int jj = 0; jj < 4; ++jj) { const int rr = r + jj - 2; x[t][jj] = (rr >= lo && rr < hi) ? *(const u32x4*)(PROJ + (size_t)rr * NPROJ + col) : (u32x4){0u, 0u, 0u, 0u}; } }
}
__device__ __forceinline__ void ev_prep_compute(const Args& a, int r, int qt, int lane, const u32x4 (&x)[2][4], const LAS float* cwq, const LAS float* cwl, const LAS float* cbl) {
    bf16* QN = (bf16*)(a.ws + WS_QN); bf16* KN = (bf16*)(a.ws + WS_KN); bf16* VC = (bf16*)(a.ws + WS_VC); bf16* XC = (bf16*)(a.ws + WS_XC);
    asm volatile("" ::: "memory");
    const bool lru = (qt == 3);
#pragma unroll
    for (int t = 0; t < 2; ++t) {
        const int ch0 = lru ? (t * 64 + lane) * 8 : ((2 * qt + t) * 64 + lane) * 8;
        const LAS float* cw = lru ? cwl : cwq; const int cstride = lru ? 1024 : 3072;
        float acc[8];
        if (lru) { const f32x4 b0 = *(const LAS f32x4*)(cbl + ch0), b1 = *(const LAS f32x4*)(cbl + ch0 + 4);
#pragma unroll
            for (int e = 0; e < 4; ++e) { acc[e] = b0[e]; acc[4 + e] = b1[e]; } }
        else {
#pragma unroll
            for (int e = 0; e < 8; ++e) acc[e] = 0.f; }
#pragma unroll
        for (int jj = 0; jj < 4; ++jj) { float xv[8]; unpack8(x[t][jj], xv);
            const f32x4 w0 = *(const LAS f32x4*)(cw + jj * cstride + ch0), w1 = *(const LAS f32x4*)(cw + jj * cstride + ch0 + 4);
#pragma unroll
            for (int e = 0; e < 4; ++e) { acc[e] += xv[e] * w0[e]; acc[4 + e] += xv[4 + e] * w1[e]; } }
        if (lru) { *(u32x4*)(XC + (size_t)r * 1024 + ch0) = pack8(acc); }
        else {
            float ss = 0.f;
#pragma unroll
            for (int e = 0; e < 8; ++e) { acc[e] = siluf_(acc[e]); ss += acc[e] * acc[e]; }
            if (qt < 2) { ss = sum16(ss); const float sc = (1.0f / sqrtf(ss + EPS)) * (qt == 0 ? 0.08838834764831845f : 1.0f);
#pragma unroll
                for (int e = 0; e < 8; ++e) acc[e] *= sc; }
            bf16* dst = (qt == 0 ? QN : (qt == 1 ? KN : VC)) + (size_t)r * 1024 + (ch0 - 1024 * qt);
            *(u32x4*)dst = pack8(acc);
        }
    }
    if (qt == 3 && lane < 16) {
        const float* AUX = (const float*)(a.ws + WS_AUX); float* G = (float*)(a.ws + WS_GB); float* BETA = G + 16 * MT;
        const float araw = AUX[(size_t)r * 32 + lane], braw = AUX[(size_t)r * 32 + 16 + lane];
        G[(size_t)lane * MT + r] = -fexp(a.in[IN_ALOG][lane]) * softplusf_(araw + a.in[IN_DTB][lane]);
        BETA[(size_t)lane * MT + r] = sigmoidf_(braw);
    }
}

constexpr int NCH = MT / 64;
__device__ __forceinline__ int scan_row(int step, int d) { return step < CT ? T + (d ? CT - 1 - step : step) : (d ? T - 1 - (step - CT) : (step - CT)); }


#define LDS_BARRIER() do { asm volatile("s_waitcnt lgkmcnt(0)" ::: "memory"); __builtin_amdgcn_s_barrier(); asm volatile("" ::: "memory"); } while (0)
constexpr int DNB_W = 0, DNB_KT = 16384, DNB_QK = 32768, DNB_U = 40960, DNB_EG = 57344, DNB_GL = 57600, DNB_STRIDE = 57856;
constexpr int DN_WAVE_LDS = 16384 + 512;
__device__ __forceinline__ bf16x8 mk8(unsigned a, unsigned b, unsigned c, unsigned d) { u32x4 v = {a, b, c, d}; return __builtin_bit_cast(bf16x8, v); }
__device__ __forceinline__ f32x4 mfma16(bf16x8 a, bf16x8 b, f32x4 c) { return __builtin_amdgcn_mfma_f32_16x16x32_bf16(a, b, c, 0, 0, 0); }
__device__ __forceinline__ u32x2 pack4(const f32x4 v) { u32x2 w; w.x = cvt_pk_bf16(v[0], v[1]); w.y = cvt_pk_bf16(v[2], v[3]); return w; }
__device__ __forceinline__ bf16x8 pack_pair(const f32x4 lo, const f32x4 hi) { return mk8(cvt_pk_bf16(lo[0], lo[1]), cvt_pk_bf16(lo[2], lo[3]), cvt_pk_bf16(hi[0], hi[1]), cvt_pk_bf16(hi[2], hi[3])); }

__device__ __forceinline__ void dn_prep_unit(const Args& a, LAS unsigned char* wl, int unit, int lane) {
    const int c = unit % NCH, hd = unit / NCH, h = hd & 7, d = hd >> 3;
    const int m = lane & 15, q = lane >> 4;
    const bf16* QN = (const bf16*)(a.ws + WS_QN); const bf16* KN = (const bf16*)(a.ws + WS_KN); const bf16* VC = (const bf16*)(a.ws + WS_VC);
    const float* G = (const float*)(a.ws + WS_GB); const float* BETA = G + 16 * MT;
    unsigned char* blob = a.ws + WS_DNB + (size_t)unit * DNB_STRIDE;
    LAS float* Al = (LAS float*)wl; LAS float* gcs = (LAS float*)(wl + 16384); LAS float* bts = gcs + 64;
    size_t rowoff[4];
#pragma unroll
    for (int mt = 0; mt < 4; ++mt) rowoff[mt] = (size_t)scan_row(64 * c + 16 * mt + m, d) * 1024 + h * 128 + 8 * q;
    bf16x8 KA[4][4];
#pragma unroll
    for (int mt = 0; mt < 4; ++mt)
#pragma unroll
        for (int kb = 0; kb < 4; ++kb) KA[mt][kb] = *(const bf16x8*)(KN + rowoff[mt] + 32 * kb);
    const int rl = scan_row(64 * c + lane, d);
    float gc = G[(size_t)(d * 8 + h) * MT + rl]; const float bp = BETA[(size_t)(d * 8 + h) * MT + rl];
#pragma unroll
    for (int o = 1; o < 64; o <<= 1) { const float t = __shfl_up(gc, o); if (lane >= o) gc += t; }
    const float gl = __shfl(gc, 63);
    gcs[lane] = gc; bts[lane] = bp;
    ((float*)(blob + DNB_EG))[lane] = fexp(gc);
    if (lane == 0) *(float*)(blob + DNB_GL) = fexp(gl);
    f32x4 gci[4], bti[4]; float gcm[4];
#pragma unroll
    for (int mt = 0; mt < 4; ++mt) { gci[mt] = *(const LAS f32x4*)(gcs + 16 * mt + 4 * q); bti[mt] = *(const LAS f32x4*)(bts + 16 * mt + 4 * q); gcm[mt] = gcs[16 * mt + m]; }
    {
#pragma unroll
    for (int mt = 0; mt < 4; ++mt)
#pragma unroll
        for (int nt = 0; nt < 4; ++nt) if (nt <= mt) {
            f32x4 acc = {0.f, 0.f, 0.f, 0.f};
#pragma unroll
            for (int kb = 0; kb < 4; ++kb) acc = mfma16(KA[mt][kb], KA[nt][kb], acc);
#pragma unroll
            for (int e = 0; e < 4; ++e) { const int i = 16 * mt + 4 * q + e, j = 16 * nt + m; Al[i * 64 + j] = (j < i) ? acc[e] * bti[mt][e] * fexp(gci[mt][e] - gcm[nt]) : 0.f; }
        } else {
#pragma unroll
            for (int e = 0; e < 4; ++e) Al[(16 * mt + 4 * q + e) * 64 + 16 * nt + m] = 0.f;
        }
    {
#pragma unroll
        for (int mt = 0; mt < 4; ++mt) {
            bf16x8 QAm[4];
#pragma unroll
            for (int kb = 0; kb < 4; ++kb) QAm[kb] = *(const bf16x8*)(QN + rowoff[mt] + 32 * kb);
#pragma unroll
            for (int t = 0; t < 4; ++t) {
                f32x4 acc = {0.f, 0.f, 0.f, 0.f};
                if (t <= mt) {
#pragma unroll
                    for (int kb = 0; kb < 4; ++kb) acc = mfma16(KA[t][kb], QAm[kb], acc);
#pragma unroll
                    for (int e = 0; e < 4; ++e) { const int j = 16 * t + 4 * q + e, i = 16 * mt + m; acc[e] = (j <= i) ? acc[e] * fexp(gcm[mt] - gci[t][e]) : 0.f; }
                }
                *(u32x2*)(blob + DNB_QK + ((mt * 2 + (t >> 1)) * 64 + lane) * 16 + (t & 1) * 8) = pack4(acc);
            }
        }
    }
    }
    for (int b = 0; b < 4; ++b) {
        float acc[16];
#pragma unroll
        for (int r = 0; r < 16; ++r) acc[r] = (lane == 16 * b + r) ? 1.f : 0.f;
        for (int jb = 0; jb < b; ++jb) {
            float tj[16];
#pragma unroll
            for (int j = 0; j < 16; ++j) tj[j] = Al[(16 * jb + j) * 64 + lane];
#pragma unroll
            for (int r = 0; r < 16; ++r) {
#pragma unroll
                for (int j4 = 0; j4 < 4; ++j4) { const f32x4 av = *(const LAS f32x4*)(Al + (16 * b + r) * 64 + 16 * jb + 4 * j4);
                    acc[r] -= av[0] * tj[4 * j4] + av[1] * tj[4 * j4 + 1] + av[2] * tj[4 * j4 + 2] + av[3] * tj[4 * j4 + 3]; } }
        }
#pragma unroll
        for (int r = 1; r < 16; ++r) {
#pragma unroll
            for (int j4 = 0; j4 < (r + 3) / 4; ++j4) { const f32x4 av = *(const LAS f32x4*)(Al + (16 * b + r) * 64 + 16 * b + 4 * j4);
#pragma unroll
                for (int e = 0; e < 4; ++e) if (4 * j4 + e < r) acc[r] -= av[e] * acc[4 * j4 + e]; } }
#pragma unroll
        for (int r = 0; r < 16; ++r) Al[(16 * b + r) * 64 + lane] = acc[r];
    }
    bf16x8 TA[4][2];
#pragma unroll
    for (int mt = 0; mt < 4; ++mt)
#pragma unroll
        for (int kb = 0; kb < 2; ++kb) { const f32x4 p0 = *(const LAS f32x4*)(Al + (16 * mt + m) * 64 + 32 * kb + 4 * q), p1 = *(const LAS f32x4*)(Al + (16 * mt + m) * 64 + 32 * kb + 16 + 4 * q);
            TA[mt][kb] = pack_pair(p0, p1);
            }
    bf16x8 id0, id1;
#pragma unroll
    for (int jj = 0; jj < 8; ++jj) { id0[jj] = (8 * q + jj == m) ? (short)0x3F80 : (short)0; id1[jj] = (8 * q + jj == 16 + m) ? (short)0x3F80 : (short)0; }
    {
        asm volatile("" ::: "memory");
        bf16x8 KB[4][4];
#pragma unroll
        for (int mt = 0; mt < 4; ++mt)
#pragma unroll
            for (int kb = 0; kb < 4; ++kb) KB[mt][kb] = *(const bf16x8*)(KN + rowoff[mt] + 32 * kb);
        f32x4 sA[4], sK[4];
#pragma unroll
        for (int jt = 0; jt < 4; ++jt)
#pragma unroll
            for (int e = 0; e < 4; ++e) { sA[jt][e] = bti[jt][e] * fexp(gci[jt][e]); sK[jt][e] = fexp(gl - gci[jt][e]); }
#pragma unroll
        for (int dt = 0; dt < 8; ++dt) {
            f32x4 Kc[4];
#pragma unroll
            for (int jt = 0; jt < 4; ++jt) { Kc[jt] = mfma16(KB[jt][dt >> 1], (dt & 1) ? id1 : id0, (f32x4){0.f, 0.f, 0.f, 0.f});
                *(u32x2*)(blob + DNB_KT + ((dt * 2 + (jt >> 1)) * 64 + lane) * 16 + (jt & 1) * 8) = pack4(Kc[jt] * sK[jt]); }
            bf16x8 Aop[2];
#pragma unroll
            for (int kb = 0; kb < 2; ++kb) Aop[kb] = pack_pair(Kc[2 * kb] * sA[2 * kb], Kc[2 * kb + 1] * sA[2 * kb + 1]);
#pragma unroll
            for (int it = 0; it < 4; ++it) { f32x4 acc = {0.f, 0.f, 0.f, 0.f};
#pragma unroll
                for (int kb = 0; kb < 2; ++kb) acc = mfma16(Aop[kb], TA[it][kb], acc);
                *(u32x2*)(blob + DNB_W + ((it * 4 + (dt >> 1)) * 64 + lane) * 16 + (dt & 1) * 8) = pack4(acc); }
        }
    }
    {
        bf16x8 VA[4][4];
#pragma unroll
        for (int mt = 0; mt < 4; ++mt)
#pragma unroll
            for (int kb = 0; kb < 4; ++kb) VA[mt][kb] = *(const bf16x8*)(VC + rowoff[mt] + 32 * kb);
#pragma unroll
        for (int nt = 0; nt < 8; ++nt) {
            f32x4 Vc[4];
#pragma unroll
            for (int jt = 0; jt < 4; ++jt) Vc[jt] = mfma16(VA[jt][nt >> 1], (nt & 1) ? id1 : id0, (f32x4){0.f, 0.f, 0.f, 0.f}) * bti[jt];
            bf16x8 Vop[2];
#pragma unroll
            for (int kb = 0; kb < 2; ++kb) Vop[kb] = pack_pair(Vc[2 * kb], Vc[2 * kb + 1]);
#pragma unroll
            for (int mt = 0; mt < 4; ++mt) { f32x4 acc = {0.f, 0.f, 0.f, 0.f};
#pragma unroll
                for (int kb = 0; kb < 2; ++kb) acc = mfma16(TA[mt][kb], Vop[kb], acc);
                *(u32x2*)(blob + DNB_U + ((mt * 8 + nt) * 64 + lane) * 8) = pack4(acc); }
        }
    }
}

constexpr int DS_STAGE = 32768 + 256, DS_SX = 2 * DS_STAGE, DS_VX = DS_SX + 8192;
__device__ __forceinline__ unsigned char* dn_snap_base(const Args& a, int d, int h) { return a.ws + (d ? WS_KN : WS_H) + (size_t)(h * NCH) * 32768; }
__device__ __forceinline__ void dn_scan2(const Args& a, LAS unsigned char* lds, int tid, int h, int d, int sl) {
    const int lane = tid & 63, w = __builtin_amdgcn_readfirstlane(tid >> 6);
    unsigned char* blob0 = a.ws + WS_DNB + (size_t)((d * 8 + h) * NCH) * DNB_STRIDE;
    unsigned char* snap0 = dn_snap_base(a, d, h) + sl * 8192;
    if (w >= 4) {
        const int lt = tid - 256;
        u32x4 r0[8], r1[8], r2[8], r3[8]; float g0 = 0.f, g1 = 0.f, g2 = 0.f, g3 = 0.f;
#define DS_LOADSET(R, gx, s_) do { if ((s_) < NCH) { const unsigned char* bl_ = blob0 + (size_t)(s_) * DNB_STRIDE; \
            _Pragma("unroll") for (int i = 0; i < 8; ++i) R[i] = *(const u32x4*)(bl_ + (lt + 256 * i) * 16); \
            if (lt == 0) gx = *(const float*)(bl_ + DNB_GL); } } while (0)
#define DS_STORESET(R, gx, s_) do { if ((s_) < NCH) { LAS unsigned char* buf_ = lds + ((s_) & 1) * DS_STAGE; \
            _Pragma("unroll") for (int i = 0; i < 8; ++i) *(LAS u32x4*)(buf_ + (lt + 256 * i) * 16) = R[i]; \
            if (lt == 0) *(LAS float*)(buf_ + 32768) = gx; } } while (0)
#define DS_COPY_VN(s_) do { _Pragma("unroll") for (int i = 0; i < 2; ++i) { const int p_ = lt + 256 * i, f_ = p_ >> 7, l_ = (p_ >> 1) & 63, pc_ = p_ & 1; \
            *(u32x2*)(blob0 + (size_t)(s_) * DNB_STRIDE + DNB_U + (((2 * (f_ >> 1) + pc_) * 8 + 2 * sl + (f_ & 1)) * 64 + l_) * 8) = *(const LAS u32x2*)(lds + DS_VX + p_ * 8); } } while (0)
#define DS_COPY_SX(s_) do { _Pragma("unroll") for (int i = 0; i < 2; ++i) *(u32x4*)(snap0 + (size_t)(s_) * 32768 + (lt + 256 * i) * 16) = *(const LAS u32x4*)(lds + DS_SX + (lt + 256 * i) * 16); } while (0)
#define DS_STEP(RL, gl_, RS, gs_, s_) do { if ((s_) > 0) DS_COPY_VN((s_) - 1); DS_LOADSET(RL, gl_, (s_) + 4); LDS_BARRIER(); DS_STORESET(RS, gs_, (s_) + 1); DS_COPY_SX(s_); LDS_BARRIER(); } while (0)
        DS_LOADSET(r0, g0, 0); DS_LOADSET(r1, g1, 1); DS_LOADSET(r2, g2, 2); DS_LOADSET(r3, g3, 3); DS_STORESET(r0, g0, 0);
        LDS_BARRIER();
        for (int s = 0; s < NCH; s += 4) {
            DS_STEP(r0, g0, r1, g1, s); DS_STEP(r1, g1, r2, g2, s + 1); DS_STEP(r2, g2, r3, g3, s + 2); DS_STEP(r3, g3, r0, g0, s + 3);
        }
        DS_COPY_VN(NCH - 1);
#undef DS_LOADSET
#undef DS_STORESET
#undef DS_COPY_VN
#undef DS_COPY_SX
#undef DS_STEP
        return;
    }
    f32x4 S[2][2];
#pragma unroll
    for (int i = 0; i < 2; ++i) { S[i][0] = (f32x4){0.f, 0.f, 0.f, 0.f}; S[i][1] = (f32x4){0.f, 0.f, 0.f, 0.f}; }
    u32x2 ua[2], ub[2];
#define DS_ULOAD(U, s_) do { if ((s_) < NCH) { _Pragma("unroll") for (int nl = 0; nl < 2; ++nl) U[nl] = *(const u32x2*)(blob0 + (size_t)(s_) * DNB_STRIDE + DNB_U + ((w * 8 + 2 * sl + nl) * 64 + lane) * 8); } } while (0)
#define DS_CSTEP(U, s_) do { const LAS unsigned char* buf = lds + ((s_) & 1) * DS_STAGE; \
        _Pragma("unroll") for (int nl = 0; nl < 2; ++nl) *(LAS bf16x8*)(lds + DS_SX + ((w * 2 + nl) * 64 + lane) * 16) = pack_pair(S[0][nl], S[1][nl]); \
        LDS_BARRIER(); \
        f32x4 acc[2] = {(f32x4){0.f, 0.f, 0.f, 0.f}, (f32x4){0.f, 0.f, 0.f, 0.f}}; \
        _Pragma("unroll") for (int kb = 0; kb < 4; ++kb) { const bf16x8 af = *(const LAS bf16x8*)(buf + ((w * 4 + kb) * 64 + lane) * 16); \
            _Pragma("unroll") for (int nl = 0; nl < 2; ++nl) acc[nl] = mfma16(af, *(const LAS bf16x8*)(lds + DS_SX + ((kb * 2 + nl) * 64 + lane) * 16), acc[nl]); } \
        _Pragma("unroll") for (int nl = 0; nl < 2; ++nl) { const f32x4 uu = {bf2f(U[nl].x & 0xffffu), bf2f(U[nl].x >> 16), bf2f(U[nl].y & 0xffffu), bf2f(U[nl].y >> 16)}; \
            *(LAS u32x2*)(lds + DS_VX + (((w >> 1) * 2 + nl) * 64 + lane) * 16 + (w & 1) * 8) = pack4(uu - acc[nl]); } \
        DS_ULOAD(U, (s_) + 2); \
        LDS_BARRIER(); \
        const float glv = *(const LAS float*)(buf + 32768); \
        _Pragma("unroll") for (int i = 0; i < 2; ++i) _Pragma("unroll") for (int nl = 0; nl < 2; ++nl) { f32x4 ac = S[i][nl] * glv; \
            _Pragma("unroll") for (int kb = 0; kb < 2; ++kb) ac = mfma16(*(const LAS bf16x8*)(buf + 16384 + (((2 * w + i) * 2 + kb) * 64 + lane) * 16), *(const LAS bf16x8*)(lds + DS_VX + ((kb * 2 + nl) * 64 + lane) * 16), ac); \
            S[i][nl] = ac; } } while (0)
    DS_ULOAD(ua, 0); DS_ULOAD(ub, 1);
    LDS_BARRIER();
    for (int s = 0; s < NCH; s += 2) { DS_CSTEP(ua, s); DS_CSTEP(ub, s + 1); }
#undef DS_ULOAD
#undef DS_CSTEP
}
__device__ __forceinline__ void dn_out_unit(const Args& a, int unit, int lane) {
    const int c = unit % NCH, hd = unit / NCH, h = hd & 7, d = hd >> 3, m = lane & 15, q = lane >> 4;
    const bf16* QN = (const bf16*)(a.ws + WS_QN); bf16* ODN = (bf16*)(a.ws + WS_ODN);
    const unsigned char* blob = a.ws + WS_DNB + (size_t)unit * DNB_STRIDE;
    const unsigned char* snap = dn_snap_base(a, d, h) + (size_t)c * 32768;
    bf16x8 QF[4][4], QKF[4][2]; f32x4 eg[4]; size_t orow[4][4];
#pragma unroll
    for (int mt = 0; mt < 4; ++mt) { const bf16* qr = QN + (size_t)scan_row(64 * c + 16 * mt + m, d) * 1024 + h * 128 + 4 * q;
#pragma unroll
        for (int kb = 0; kb < 4; ++kb) { const u32x2 p0 = *(const u32x2*)(qr + 32 * kb), p1 = *(const u32x2*)(qr + 32 * kb + 16); QF[mt][kb] = mk8(p0.x, p0.y, p1.x, p1.y); }
#pragma unroll
        for (int kb = 0; kb < 2; ++kb) QKF[mt][kb] = *(const bf16x8*)(blob + DNB_QK + ((mt * 2 + kb) * 64 + lane) * 16);
        eg[mt] = *(const f32x4*)(blob + DNB_EG + (16 * mt + 4 * q) * 4);
#pragma unroll
        for (int e = 0; e < 4; ++e) orow[mt][e] = ((size_t)d * MT + scan_row(64 * c + 16 * mt + 4 * q + e, d)) * 1024 + h * 128 + m; }
#pragma unroll
    for (int nt = 0; nt < 8; ++nt) {
        bf16x8 Sf[4], Vf[2];
#pragma unroll
        for (int kb = 0; kb < 4; ++kb) Sf[kb] = *(const bf16x8*)(snap + (nt >> 1) * 8192 + ((kb * 2 + (nt & 1)) * 64 + lane) * 16);
#pragma unroll
        for (int kb = 0; kb < 2; ++kb) { const u32x2 p0 = *(const u32x2*)(blob + DNB_U + (((2 * kb) * 8 + nt) * 64 + lane) * 8), p1 = *(const u32x2*)(blob + DNB_U + (((2 * kb + 1) * 8 + nt) * 64 + lane) * 8); Vf[kb] = mk8(p0.x, p0.y, p1.x, p1.y); }
#pragma unroll
        for (int mt = 0; mt < 4; ++mt) { f32x4 acc = {0.f, 0.f, 0.f, 0.f};
#pragma unroll
            for (int kb = 0; kb < 4; ++kb) acc = mfma16(QF[mt][kb], Sf[kb], acc);
            acc = acc * eg[mt];
#pragma unroll
            for (int kb = 0; kb < 2; ++kb) acc = mfma16(QKF[mt][kb], Vf[kb], acc);
#pragma unroll
            for (int e = 0; e < 4; ++e) ODN[orow[mt][e] + 16 * nt] = f2bf(acc[e]); }
    }
}

template <int DIR> __device__ __forceinline__ void lru_item(const Args& a, int d, int n, int rt, int w, int lane, const bf16x8 (&XAall)[4][4], const bf16x8 (&WAf)[4], const bf16x8 (&WXf)[4]) {
    const int m = lane & 15, q = lane >> 4, r0 = rt * 64;
    const bf16* XC = (const bf16*)(a.ws + WS_XC); bf16* HLOC = (bf16*)(a.ws + WS_HLOC); bf16* CLB = (bf16*)(a.ws + WS_CL);
    float* AGG = (float*)(a.ws + WS_LAGG);
    bf16x8 id0, id1;
#pragma unroll
    for (int jj = 0; jj < 8; ++jj) { id0[jj] = (8 * q + jj == m) ? (short)0x3F80 : (short)0; id1[jj] = (8 * q + jj == 16 + m) ? (short)0x3F80 : (short)0; }
    f32x4 la[4], bb[4];
#pragma unroll
    for (int mt = 0; mt < 4; ++mt) { bf16x8 XA[4];
#pragma unroll
        for (int kb = 0; kb < 4; ++kb) XA[kb] = XAall[mt][kb];
        f32x4 ra = {0.f, 0.f, 0.f, 0.f}, rx = {0.f, 0.f, 0.f, 0.f};
#pragma unroll
        for (int kb = 0; kb < 4; ++kb) { ra = mfma16(XA[kb], WAf[kb], ra); rx = mfma16(XA[kb], WXf[kb], rx); }
        bb[mt] = mfma16((w >> 1) == 0 ? XA[0] : ((w >> 1) == 1 ? XA[1] : ((w >> 1) == 2 ? XA[2] : XA[3])), (w & 1) ? id1 : id0, (f32x4){0.f, 0.f, 0.f, 0.f});
        la[mt] = ra; const f32x4 t = rx;
        const int ch = 128 * n + 16 * w + m; const float ba = a.in[IN_LBA][d * 1024 + ch], bx = a.in[IN_LBX][d * 1024 + ch], sp = softplusf_(-a.in[IN_LAM][d * 1024 + ch]);
#pragma unroll
        for (int e = 0; e < 4; ++e) { const float rr = sigmoidf_(la[mt][e] + ba), gi = sigmoidf_(t[e] + bx), l = -8.0f * rr * sp; bb[mt][e] = sqrtf(1.0f - fexp(2.0f * l)) * gi * bb[mt][e]; la[mt][e] = l; }
    }
    f32x4 hl[4], cs[4]; float At[4], Ht[4];
#pragma unroll
    for (int mt = 0; mt < 4; ++mt) { float h = 0.f, c = 0.f;
#pragma unroll
        for (int ii = 0; ii < 4; ++ii) { const int e = DIR ? 3 - ii : ii; c += la[mt][e]; h = fexp(la[mt][e]) * h + bb[mt][e]; hl[mt][e] = h; cs[mt][e] = c; }
        At[mt] = c; Ht[mt] = h; }
    float hm = 0.f, am = 0.f;
#pragma unroll
    for (int bi = 0; bi < 4; ++bi) { const int mt = DIR ? 3 - bi : bi;
        float Aq[4], Hq[4];
#pragma unroll
        for (int k = 0; k < 4; ++k) { Aq[k] = __shfl(At[mt], m + 16 * k); Hq[k] = __shfl(Ht[mt], m + 16 * k); }
        float hc = 0.f, ac = 0.f, hb = 0.f, ab = 0.f;
#pragma unroll
        for (int kk = 0; kk < 4; ++kk) { const int k = DIR ? 3 - kk : kk; const bool before = DIR ? (k > q) : (k < q);
            if (before) { hc = fexp(Aq[k]) * hc + Hq[k]; ac += Aq[k]; }
            hb = fexp(Aq[k]) * hb + Hq[k]; ab += Aq[k]; }
        const float hin = fexp(ac) * hm + hc, ain = am + ac;
#pragma unroll
        for (int e = 0; e < 4; ++e) { const size_t o = ((size_t)d * MT + r0 + 16 * mt + 4 * q + e) * 1024 + 128 * n + 16 * w + m;
            HLOC[o] = f2bf(hl[mt][e] + fexp(cs[mt][e]) * hin); CLB[o] = f2bf(cs[mt][e] + ain); }
        hm = fexp(ab) * hm + hb; am += ab; }
    if (q == 0) { const int ch = 128 * n + 16 * w + m; AGG[((size_t)d * NCH + rt) * 1024 + ch] = am; AGG[((size_t)(2 + d) * NCH + rt) * 1024 + ch] = hm; }
}

__device__ __forceinline__ int scan_chunk(int s, int d) { return s < 4 ? 256 + (d ? 3 - s : s) : (d ? 255 - (s - 4) : (s - 4)); }
__device__ __forceinline__ void lru_carry(const Args& a, int id) {
    const int d = id >> 10, ch = id & 1023;
    const float* AGG = (const float*)(a.ws + WS_LAGG); float* CARRY = (float*)(a.ws + WS_LAGG) + (size_t)4 * NCH * 1024;
    float h = 0.f;
#pragma unroll 4
    for (int s = 0; s < NCH; ++s) { const int ck = scan_chunk(s, d);
        CARRY[((size_t)d * NCH + ck) * 1024 + ch] = h;
        h = fexp(AGG[((size_t)d * NCH + ck) * 1024 + ch]) * h + AGG[((size_t)(2 + d) * NCH + ck) * 1024 + ch]; }
}
__device__ __forceinline__ void ev_finish_row(const Args& a, int r, int lane, const bf16* ODN) {
    const bf16* PROJ = (const bf16*)(a.ws + WS_PROJ); const bf16* HL = (const bf16*)(a.ws + WS_HLOC); const bf16* CLB = (const bf16*)(a.ws + WS_CL); bf16* MIX = (bf16*)(a.ws + WS_MIX);
    const float* CARRY = (const float*)(a.ws + WS_LAGG) + (size_t)4 * NCH * 1024; const int ck = r >> 6;
#pragma unroll
    for (int it = 0; it < 2; ++it) {
        const int ch0 = (it * 64 + lane) * 8;
        float o0[8], o1[8], z[8], o[8]; unpack8(*(const u32x4*)(ODN + (size_t)r * 1024 + ch0), o0); unpack8(*(const u32x4*)(ODN + ((size_t)MT + r) * 1024 + ch0), o1);
        unpack8(*(const u32x4*)(PROJ + (size_t)r * NPROJ + 3072 + ch0), z);
        float ss = 0.f;
#pragma unroll
        for (int e = 0; e < 8; ++e) { o[e] = o0[e] + o1[e]; ss += o[e] * o[e]; }
        ss = sum16(ss); const float rstd = 1.0f / sqrtf(ss * (1.0f / 128.0f) + EPS);
        const f32x4 g0 = *(const f32x4*)(a.in[IN_DNG] + (ch0 & 127)), g1 = *(const f32x4*)(a.in[IN_DNG] + (ch0 & 127) + 4);
#pragma unroll
        for (int e = 0; e < 4; ++e) { o[e] = o[e] * rstd * g0[e] * siluf_(z[e]); o[4 + e] = o[4 + e] * rstd * g1[e] * siluf_(z[4 + e]); }
        *(u32x4*)(MIX + (size_t)r * D + ch0) = pack8(o);
    }
#pragma unroll
    for (int it = 0; it < 2; ++it) {
        const int ch0 = (it * 64 + lane) * 8;
        float h0[8], h1[8], c0[8], c1[8], gr[8], y[8]; unpack8(*(const u32x4*)(HL + (size_t)r * 1024 + ch0), h0); unpack8(*(const u32x4*)(HL + ((size_t)MT + r) * 1024 + ch0), h1);
        unpack8(*(const u32x4*)(CLB + (size_t)r * 1024 + ch0), c0); unpack8(*(const u32x4*)(CLB + ((size_t)MT + r) * 1024 + ch0), c1);
        unpack8(*(const u32x4*)(PROJ + (size_t)r * NPROJ + 5120 + ch0), gr);
        const f32x4 k00 = *(const f32x4*)(CARRY + (size_t)ck * 1024 + ch0), k01 = *(const f32x4*)(CARRY + (size_t)ck * 1024 + ch0 + 4);
        const f32x4 k10 = *(const f32x4*)(CARRY + ((size_t)NCH + ck) * 1024 + ch0), k11 = *(const f32x4*)(CARRY + ((size_t)NCH + ck) * 1024 + ch0 + 4);
#pragma unroll
        for (int e = 0; e < 8; ++e) { const float ka = e < 4 ? k00[e & 3] : k01[e & 3], kb = e < 4 ? k10[e & 3] : k11[e & 3];
            y[e] = ((h0[e] + fexp(c0[e]) * ka) + (h1[e] + fexp(c1[e]) * kb)) * gelu_tanh(gr[e]); }
        *(u32x4*)(MIX + (size_t)r * D + 1024 + ch0) = pack8(y);
    }
}

constexpr int GB_QD = 0, GB_KDT = 32768, GB_ATT = 65536, GB_EGL = 73728, GB_STRIDE = 74752;
constexpr int GCL_LD = 260;
__device__ __forceinline__ void gla_prep_unit(const Args& a, LAS unsigned char* lds, int tid, int unit) {
    const int c = unit % NCH, hd = unit / NCH, h = hd & 3, d = hd >> 2;
    const int lane = tid & 63, wave = __builtin_amdgcn_readfirstlane(tid >> 6), m = lane & 15, q = lane >> 4;
    const bf16* PROJ = (const bf16*)(a.ws + WS_PROJ); const float* AUX = (const float*)(a.ws + WS_AUX);
    unsigned char* blob = a.ws + WS_GLB + (size_t)unit * GB_STRIDE;
    LAS float* gcl = (LAS float*)lds;
    {
        LAS float* gds = gcl + 64 * GCL_LD;
        for (int i = tid; i < 64 * 16; i += NTHREADS) gds[i] = AUX[(size_t)scan_row(64 * c + (i >> 4), d) * 32 + d * 16 + (i & 15)];
        const int ch = tid & 255, half = tid >> 8;
        float wg[16];
#pragma unroll
        for (int r = 0; r < 16; ++r) wg[r] = a.in[IN_WG2][(size_t)(d * 16 + r) * 1024 + h * 256 + ch];
        const float bgc = a.in[IN_BG][d * 1024 + h * 256 + ch];
        __syncthreads();
        float run = 0.f;
#pragma unroll 4
        for (int pp = 0; pp < 32; ++pp) { const int p = 32 * half + pp; const LAS float* gd = gds + p * 16;
            const f32x4 g0 = *(const LAS f32x4*)(gd), g1 = *(const LAS f32x4*)(gd + 4), g2 = *(const LAS f32x4*)(gd + 8), g3 = *(const LAS f32x4*)(gd + 12);
            float lg = bgc;
#pragma unroll
            for (int r = 0; r < 4; ++r) { lg += g0[r] * wg[r]; lg += g1[r] * wg[4 + r]; lg += g2[r] * wg[8 + r]; lg += g3[r] * wg[12 + r]; }
            run += (fminf(lg, 0.f) - flog(1.0f + fexp(-fabsf(lg)))) * 0.0625f;
            gcl[p * GCL_LD + ch] = run; }
        __syncthreads();
        if (half) { const float tot = gcl[31 * GCL_LD + ch];
#pragma unroll 8
            for (int pp = 0; pp < 32; ++pp) gcl[(32 + pp) * GCL_LD + ch] += tot; }
        __syncthreads();
        if (tid < 256) ((float*)(blob + GB_EGL))[tid] = fexp(gcl[63 * GCL_LD + tid]);
    }
    size_t rrow[4];
#pragma unroll
    for (int t = 0; t < 4; ++t) rrow[t] = (size_t)scan_row(64 * c + 16 * t + m, d) * NPROJ + h * 256 + 8 * q;
    bf16x8 id0, id1;
#pragma unroll
    for (int jj = 0; jj < 8; ++jj) { id0[jj] = (8 * q + jj == m) ? (short)0x3F80 : (short)0; id1[jj] = (8 * q + jj == 16 + m) ? (short)0x3F80 : (short)0; }
    {
        bf16x8 qbf[8], kaf[8];
#pragma unroll
        for (int i = 0; i < 8; ++i) { const int tile = wave + 8 * i, it = tile >> 4, dt = tile & 15;
            qbf[i] = *(const bf16x8*)(PROJ + rrow[it] + 32 * (dt >> 1)); kaf[i] = *(const bf16x8*)(PROJ + rrow[it] + 1024 + 32 * (dt >> 1)); }
#pragma unroll
        for (int i = 0; i < 8; ++i) {
            const int tile = wave + 8 * i, it = tile >> 4, dt = tile & 15;
            {
                f32x4 dq = mfma16((dt & 1) ? id1 : id0, qbf[i], (f32x4){0.f, 0.f, 0.f, 0.f});
                const f32x4 gv = *(const LAS f32x4*)(gcl + (16 * it + m) * GCL_LD + 16 * dt + 4 * q);
#pragma unroll
                for (int e = 0; e < 4; ++e) dq[e] *= fexp(gv[e]) * 0.0625f;
                *(u32x2*)(blob + GB_QD + ((it * 8 + (dt >> 1)) * 64 + lane) * 16 + (dt & 1) * 8) = pack4(dq);
            }
            {
                f32x4 dk_ = mfma16(kaf[i], (dt & 1) ? id1 : id0, (f32x4){0.f, 0.f, 0.f, 0.f});
                const float gl = gcl[63 * GCL_LD + 16 * dt + m];
#pragma unroll
                for (int e = 0; e < 4; ++e) dk_[e] *= fexp(gl - gcl[(16 * it + 4 * q + e) * GCL_LD + 16 * dt + m]);
                *(u32x2*)(blob + GB_KDT + ((dt * 2 + (it >> 1)) * 64 + lane) * 16 + (it & 1) * 8) = pack4(dk_);
            }
        }
    }
    LAS f32x4* part = (LAS f32x4*)(lds + 70656);
    {
        bf16x8 KI[4], QDn[4];
#pragma unroll
        for (int t = 0; t < 4; ++t) { float kx[8], qx[8];
            unpack8(*(const u32x4*)(PROJ + rrow[t] + 1024 + 32 * wave), kx); unpack8(*(const u32x4*)(PROJ + rrow[t] + 32 * wave), qx);
            const f32x4 g0 = *(const LAS f32x4*)(gcl + (16 * t + m) * GCL_LD + 32 * wave + 8 * q), g1 = *(const LAS f32x4*)(gcl + (16 * t + m) * GCL_LD + 32 * wave + 8 * q + 4);
#pragma unroll
            for (int e = 0; e < 4; ++e) { kx[e] *= fexp(-g0[e]); kx[4 + e] *= fexp(-g1[e]); qx[e] *= fexp(g0[e]) * 0.0625f; qx[4 + e] *= fexp(g1[e]) * 0.0625f; }
            const u32x4 kp = pack8(kx), qp = pack8(qx); KI[t] = __builtin_bit_cast(bf16x8, kp); QDn[t] = __builtin_bit_cast(bf16x8, qp); }
        int ti = 0;
#pragma unroll
        for (int mt = 0; mt < 4; ++mt)
#pragma unroll
            for (int t = 0; t < 4; ++t) if (t <= mt) { part[(wave * 10 + ti) * 64 + lane] = mfma16(KI[t], QDn[mt], (f32x4){0.f, 0.f, 0.f, 0.f}); ++ti; }
    }
    __syncthreads();
    for (int ti = wave; ti < 10; ti += 8) {
        const int mt = ti >= 6 ? 3 : (ti >= 3 ? 2 : (ti >= 1 ? 1 : 0)), t = ti - mt * (mt + 1) / 2;
        f32x4 acc = part[ti * 64 + lane];
#pragma unroll
        for (int ww = 1; ww < 8; ++ww) acc += part[(ww * 10 + ti) * 64 + lane];
#pragma unroll
        for (int e = 0; e < 4; ++e) { const int j = 16 * t + 4 * q + e, i = 16 * mt + m; if (j > i) acc[e] = 0.f; }
        *(u32x2*)(blob + GB_ATT + ((mt * 2 + (t >> 1)) * 64 + lane) * 16 + (t & 1) * 8) = pack4(acc);
    }
    if (wave >= 2) { const int z = wave - 2, mt = z < 3 ? 0 : (z < 5 ? 1 : 2), t = z < 3 ? z + 1 : (z < 5 ? z - 1 : 3);
        *(u32x2*)(blob + GB_ATT + ((mt * 2 + (t >> 1)) * 64 + lane) * 16 + (t & 1) * 8) = (u32x2){0u, 0u}; }
    __syncthreads();
}

constexpr int GSEG = 8;
__device__ __forceinline__ int gseg_begin(int g) { return g == 0 ? 0 : 36 + 32 * (g - 1); }
template <int MODE> __device__ __forceinline__ void gla_scan(const Args& a, LAS unsigned char* lds, int tid, int h, int d, int qv, int g) {
    const int lane = tid & 63, w = __builtin_amdgcn_readfirstlane(tid >> 6), m = lane & 15, q = lane >> 4;
    const bf16* PROJ = (const bf16*)(a.ws + WS_PROJ); bf16* OG = (bf16*)(a.ws + WS_OGLA);
    const unsigned char* blob0 = a.ws + WS_GLB + (size_t)((d * 4 + h) * NCH) * GB_STRIDE;
    float* ZB = (float*)(a.ws + WS_GLZ); float* SEGDEC = (float*)(a.ws + WS_GLZ + 32 * MiB);
    const int c0 = gseg_begin(g), c1 = gseg_begin(g + 1);
    constexpr int NPIECE = GB_STRIDE / 16, P0 = MODE ? 0 : GB_KDT / 16, NSET = MODE ? 19 : 11;
    if (w >= 4) {
        const int lt = tid - 256;
        u32x4 ra[NSET], rb[NSET]; float prod = 1.0f;
#define GL_LOADSET(R, s_) do { if ((s_) < c1) { const unsigned char* bl_ = blob0 + (size_t)(s_) * GB_STRIDE; \
            _Pragma("unroll") for (int i = 0; i < NSET; ++i) { const int p = P0 + lt + 256 * i; if (p < NPIECE) R[i] = *(const u32x4*)(bl_ + p * 16); } \
            if (MODE == 0) prod *= *(const float*)(bl_ + GB_EGL + lt * 4); } } while (0)
#define GL_STORESET(R, s_) do { if ((s_) < c1) { LAS unsigned char* buf_ = lds + (((s_) - c0) & 1) * GB_STRIDE; \
            _Pragma("unroll") for (int i = 0; i < NSET; ++i) { const int p = P0 + lt + 256 * i; if (p < NPIECE) *(LAS u32x4*)(buf_ + p * 16) = R[i]; } } } while (0)
        GL_LOADSET(ra, c0); GL_LOADSET(rb, c0 + 1);
        GL_STORESET(ra, c0);
        LDS_BARRIER();
        for (int s = c0; s < c1; s += 2) {
            GL_LOADSET(ra, s + 2); GL_STORESET(rb, s + 1); LDS_BARRIER();
            GL_LOADSET(rb, s + 3); GL_STORESET(ra, s + 2); LDS_BARRIER();
        }
#undef GL_LOADSET
#undef GL_STORESET
        if (MODE == 0 && qv == 0) SEGDEC[((d * 4 + h) * GSEG + g) * 256 + lt] = prod;
        return;
    }
    const int colbase = 2048 + h * 512 + qv * 128 + 32 * w;
    bf16x8 id0, id1;
#pragma unroll
    for (int jj = 0; jj < 8; ++jj) { id0[jj] = (8 * q + jj == m) ? (short)0x3F80 : (short)0; id1[jj] = (8 * q + jj == 16 + m) ? (short)0x3F80 : (short)0; }
    f32x4 S[16][2];
#pragma unroll
    for (int i = 0; i < 16; ++i) { S[i][0] = (f32x4){0.f, 0.f, 0.f, 0.f}; S[i][1] = (f32x4){0.f, 0.f, 0.f, 0.f}; }
    if (MODE == 1) {
        for (int gp = 0; gp < g; ++gp) { const float* zp = ZB + ((size_t)((((d * 4 + h) * 4 + qv) * GSEG + gp) * 4 + w) * 32) * 256 + lane * 4; const float* dp = SEGDEC + ((d * 4 + h) * GSEG + gp) * 256 + 4 * q;
#pragma unroll
            for (int dt = 0; dt < 16; ++dt) { const f32x4 dc = *(const f32x4*)(dp + 16 * dt);
                S[dt][0] = S[dt][0] * dc + *(const f32x4*)(zp + (dt * 2 + 0) * 256); S[dt][1] = S[dt][1] * dc + *(const f32x4*)(zp + (dt * 2 + 1) * 256); } }
    }
    bf16x8 VA[4];
#pragma unroll
    for (int mt = 0; mt < 4; ++mt) VA[mt] = *(const bf16x8*)(PROJ + (size_t)scan_row(64 * c0 + 16 * mt + m, d) * NPROJ + colbase + 8 * q);
    LDS_BARRIER();
    for (int s = c0; s < c1; ++s) {
        const LAS unsigned char* buf = lds + ((s - c0) & 1) * GB_STRIDE;
        bf16x8 Vb[2][2];
#pragma unroll
        for (int nt = 0; nt < 2; ++nt) { f32x4 vc[4];
#pragma unroll
            for (int mt = 0; mt < 4; ++mt) vc[mt] = mfma16(VA[mt], nt ? id1 : id0, (f32x4){0.f, 0.f, 0.f, 0.f});
            Vb[nt][0] = pack_pair(vc[0], vc[1]); Vb[nt][1] = pack_pair(vc[2], vc[3]); }
        if (s + 1 < c1) {
#pragma unroll
            for (int mt = 0; mt < 4; ++mt) VA[mt] = *(const bf16x8*)(PROJ + (size_t)scan_row(64 * (s + 1) + 16 * mt + m, d) * NPROJ + colbase + 8 * q); }
        if (MODE == 1 && s >= 4) {
            f32x4 o[4][2];
#pragma unroll
            for (int mt = 0; mt < 4; ++mt) { o[mt][0] = (f32x4){0.f, 0.f, 0.f, 0.f}; o[mt][1] = (f32x4){0.f, 0.f, 0.f, 0.f}; }
            bf16x8 af[2][4];
#define GL_AFRAG(ks_, mt_) (*(const LAS bf16x8*)(buf + ((ks_) < 8 ? GB_QD + (((mt_) * 8 + (ks_)) * 64 + lane) * 16 : GB_ATT + (((mt_) * 2 + ((ks_) - 8)) * 64 + lane) * 16)))
#pragma unroll
            for (int mt = 0; mt < 4; ++mt) af[0][mt] = GL_AFRAG(0, mt);
#pragma unroll
            for (int ks = 0; ks < 10; ++ks) {
                if (ks + 1 < 10) {
#pragma unroll
                    for (int mt = 0; mt < 4; ++mt) af[(ks + 1) & 1][mt] = GL_AFRAG(ks + 1, mt); }
                bf16x8 b0, b1;
                if (ks < 8) { b0 = pack_pair(S[2 * (ks & 7)][0], S[2 * (ks & 7) + 1][0]); b1 = pack_pair(S[2 * (ks & 7)][1], S[2 * (ks & 7) + 1][1]); }
                else { b0 = Vb[0][ks & 1]; b1 = Vb[1][ks & 1]; }
#pragma unroll
                for (int mt = 0; mt < 4; ++mt) { o[mt][0] = mfma16(af[ks & 1][mt], b0, o[mt][0]); o[mt][1] = mfma16(af[ks & 1][mt], b1, o[mt][1]); }
            }
#undef GL_AFRAG
#pragma unroll
            for (int mt = 0; mt < 4; ++mt)
#pragma unroll
                for (int e = 0; e < 4; ++e) { const size_t ro = ((size_t)d * T + scan_row(64 * s + 16 * mt + 4 * q + e, d)) * D + (colbase - 2048) + m;
                    OG[ro] = f2bf(o[mt][0][e]); OG[ro + 16] = f2bf(o[mt][1][e]); }
        }
        {
            bf16x8 kf[2][2]; f32x4 egs[2];
            kf[0][0] = *(const LAS bf16x8*)(buf + GB_KDT + ((0 * 2 + 0) * 64 + lane) * 16); kf[0][1] = *(const LAS bf16x8*)(buf + GB_KDT + ((0 * 2 + 1) * 64 + lane) * 16);
            egs[0] = *(const LAS f32x4*)(buf + GB_EGL + (4 * q) * 4);
#pragma unroll
            for (int dt = 0; dt < 16; ++dt) {
                if (dt + 1 < 16) { kf[(dt + 1) & 1][0] = *(const LAS bf16x8*)(buf + GB_KDT + (((dt + 1) * 2 + 0) * 64 + lane) * 16); kf[(dt + 1) & 1][1] = *(const LAS bf16x8*)(buf + GB_KDT + (((dt + 1) * 2 + 1) * 64 + lane) * 16);
                    egs[(dt + 1) & 1] = *(const LAS f32x4*)(buf + GB_EGL + (16 * (dt + 1) + 4 * q) * 4); }
                f32x4 a0 = S[dt][0] * egs[dt & 1], a1 = S[dt][1] * egs[dt & 1];
                a0 = mfma16(kf[dt & 1][0], Vb[0][0], a0); a1 = mfma16(kf[dt & 1][0], Vb[1][0], a1);
                a0 = mfma16(kf[dt & 1][1], Vb[0][1], a0); a1 = mfma16(kf[dt & 1][1], Vb[1][1], a1);
                S[dt][0] = a0; S[dt][1] = a1; }
        }
        LDS_BARRIER();
    }
    if (MODE == 0) { float* zp = ZB + ((size_t)((((d * 4 + h) * 4 + qv) * GSEG + g) * 4 + w) * 32) * 256 + lane * 4;
#pragma unroll
        for (int dt = 0; dt < 16; ++dt) { *(f32x4*)(zp + (dt * 2 + 0) * 256) = S[dt][0]; *(f32x4*)(zp + (dt * 2 + 1) * 256) = S[dt][1]; } }
}

__device__ __forceinline__ void od_finish_row(const Args& a, int n, int lane) {
    const int p = (n & 63) * 256 + (n >> 6);
    const bf16* PROJ = (const bf16*)(a.ws + WS_PROJ); const bf16* OG = (const bf16*)(a.ws + WS_OGLA); bf16* MIX = (bf16*)(a.ws + WS_MIX);
#pragma unroll
    for (int it = 0; it < 4; ++it) {
        const int ch0 = it * 512 + lane * 8;
        float o0[8], o1[8], go[8], o[8]; unpack8(*(const u32x4*)(OG + (size_t)p * D + ch0), o0); unpack8(*(const u32x4*)(OG + ((size_t)T + p) * D + ch0), o1);
        unpack8(*(const u32x4*)(PROJ + (size_t)p * NPROJ + 4096 + ch0), go);
        float ss = 0.f;
#pragma unroll
        for (int e = 0; e < 8; ++e) { o[e] = o0[e] + o1[e]; ss += o[e] * o[e]; }
        ss = wave_sum(ss); const float rstd = 1.0f / sqrtf(ss * (1.0f / 512.0f) + EPS);
        const f32x4 g0 = *(const f32x4*)(a.in[IN_GLAG] + lane * 8), g1 = *(const f32x4*)(a.in[IN_GLAG] + lane * 8 + 4);
#pragma unroll
        for (int e = 0; e < 4; ++e) { o[e] = o[e] * rstd * g0[e] * siluf_(go[e]); o[4 + e] = o[4 + e] * rstd * g1[e] * siluf_(go[4 + e]); }
        *(u32x4*)(MIX + (size_t)n * D + ch0) = pack8(o);
    }
}

__global__ void __launch_bounds__(NTHREADS, 2) fwd_kernel(Args args) {
    extern __shared__ __attribute__((aligned(16))) unsigned char lds_raw[];
    LAS unsigned char* lds = (LAS unsigned char*)lds_raw;
    const int tid = threadIdx.x, lane = tid & 63, wave = __builtin_amdgcn_readfirstlane(tid >> 6);
    const int G = gridDim.x, gw = blockIdx.x * NWAVES + wave, NGW = G * NWAVES;
    unsigned char* ws = args.ws;
    unsigned* ctl = (unsigned*)(ws + WS_CTL);
    volatile LAS unsigned* MISC = (volatile LAS unsigned*)(lds + LDSCTL_OFF);
    for (int u = tid; u < (LDS_BYTES - LDSCTL_OFF) / 4; u += NTHREADS) ((LAS unsigned*)(lds + LDSCTL_OFF))[u] = 0u;
    __syncthreads();
    XcdBarrier bar = xcd_barrier_post(ctl + CW_BAR, MISC + 8);
#define GRID_BAR() xcd_barrier(bar)
    const int lo = args.ph_lo, hi = args.ph_hi;
#define IN(k) (lo <= (k) && (k) < hi)
#define BOTH(k) (IN(k) && IN((k) + 1))
    float* MOD = (float*)(ws + WS_MOD);
#define MODV(layer, cond, j) (MOD + (((layer) * 2 + (cond)) * 6 + (j)) * D)
    float* XRES = (float*)(ws + WS_XRES);
    bf16* H = (bf16*)(ws + WS_H);
    bf16* MIX = (bf16*)(ws + WS_MIX);

    if (IN(0)) {
        p0_adaln(args, lds, tid, 0, (int)blockIdx.x, G);
        LAS float* scr = (LAS float*)(lds + wave * 16384);
        transpose_job<3>(args.in[IN_EVWIN], D, EV_IN, (bf16*)(ws + WS_W_EVIN), scr, gw, NGW, lane);
        { bf16* WT = (bf16*)(ws + WS_SMALL + SM_LRUW);
          for (int i = blockIdx.x * NTHREADS + tid; i < 2 * 8 * 2 * 128 * 128; i += G * NTHREADS) { const int c = i & 127, mm = (i >> 7) & 127, mat = (i >> 14) & 1, dn = i >> 15;
              WT[i] = f2bf((mat ? args.in[IN_LWX] : args.in[IN_LWA])[((size_t)dn * 128 + c) * 128 + mm]); } }
        if (BOTH(0)) GRID_BAR();
    }
    if (IN(1)) {
        LAS float* nA = (LAS float*)lds; LAS float* nB = nA + D;
        norm_stage_ab(nA, nB, args.in[IN_N1G], MODV(0, 0, 0), MODV(0, 0, 1), tid); __syncthreads();
        for (int r = gw; r < MT; r += NGW) { const int cond = r >= T; f32x4 hv[8];
            if (cond) norm_row(args.in[IN_CTX] + (size_t)(r - T) * D, args.in[IN_N1G], MODV(0, 1, 0), MODV(0, 1, 1), H + (size_t)r * D, nullptr, lane, hv);
            else norm_row_ab(args.in[IN_X] + (size_t)r * D, nA, nB, H + (size_t)r * D, lane, hv); }
        if (BOTH(1)) GRID_BAR();
    }
    if (IN(2)) {
        if ((int)blockIdx.x < XC_GW2) {
        pg8::Gemm g{H, (const bf16*)(ws + WS_W_EVIN), MT, NPROJ_PAD, D, D}; pg8::StaticOrder S; S.init(MT, NPROJ_PAD, XC_GW2, (int)blockIdx.x);
        pg8::EpiProj E{(bf16*)(ws + WS_PROJ), (float*)(ws + WS_AUX), NPROJ, NPROJ / 256};
        pg8::gemm_phase<pg8::EpiProj, pg8::StaticOrder, true, true>(lds, g, S, E);
        } else expert_convert_range(args, (LAS float*)(lds + wave * 16384), XC_B0, XC_B1, ((int)blockIdx.x - XC_GW2) * NWAVES + wave, (G - XC_GW2) * NWAVES, lane);
        if (BOTH(2)) GRID_BAR();
    }
    if (IN(3)) {
        { LAS float* cwq = (LAS float*)lds; LAS float* cwl = cwq + 4 * 3072; LAS float* cbl = cwl + 4 * 1024;
          for (int i = tid; i < 3072; i += NTHREADS) ((LAS f32x4*)cwq)[i] = ((const f32x4*)args.in[IN_EVCONV])[i];
          for (int i = tid; i < 1024; i += NTHREADS) ((LAS f32x4*)cwl)[i] = ((const f32x4*)args.in[IN_LCW])[i];
          for (int i = tid; i < 256; i += NTHREADS) ((LAS f32x4*)cbl)[i] = ((const f32x4*)args.in[IN_LCB])[i];
          __syncthreads();
          u32x4 xa[2][4], xb[2][4]; int r = gw;
          if (r < MT) ev_prep_load(args, r, 0, lane, xa);
          while (r < MT) { const int rn = r + NGW;
              ev_prep_load(args, r, 1, lane, xb); ev_prep_compute(args, r, 0, lane, xa, cwq, cwl, cbl);
              ev_prep_load(args, r, 2, lane, xa); ev_prep_compute(args, r, 1, lane, xb, cwq, cwl, cbl);
              ev_prep_load(args, r, 3, lane, xb); ev_prep_compute(args, r, 2, lane, xa, cwq, cwl, cbl);
              if (rn < MT) ev_prep_load(args, rn, 0, lane, xa);
              ev_prep_compute(args, r, 3, lane, xb, cwq, cwl, cbl); r = rn; } }
        if (BOTH(3)) GRID_BAR();
    }
    if (IN(4)) {
        {
            const bf16* XC = (const bf16*)(ws + WS_XC); const unsigned* WT32 = (const unsigned*)(ws + WS_SMALL + SM_LRUW); const int m_ = lane & 15, q_ = lane >> 4;
            const int dn = (int)blockIdx.x >> 4, n = dn & 7, d = dn >> 3;
            bf16x8 WAf[4], WXf[4];
#pragma unroll
            for (int kb = 0; kb < 4; ++kb) { const unsigned* pa = WT32 + (((size_t)((dn * 2 + 0) * 128 + 16 * wave + m_)) * 128 + 32 * kb + 8 * q_) / 2; const unsigned* px = WT32 + (((size_t)((dn * 2 + 1) * 128 + 16 * wave + m_)) * 128 + 32 * kb + 8 * q_) / 2;
                u32x4 va, vx;
#pragma unroll
                for (int j = 0; j < 4; ++j) { va[j] = __hip_atomic_load(pa + j, __ATOMIC_RELAXED, __HIP_MEMORY_SCOPE_AGENT); vx[j] = __hip_atomic_load(px + j, __ATOMIC_RELAXED, __HIP_MEMORY_SCOPE_AGENT); }
                WAf[kb] = __builtin_bit_cast(bf16x8, va); WXf[kb] = __builtin_bit_cast(bf16x8, vx); }
            bf16x8 XAc[4][4];
#define LRU_XLOAD(X, rt_) do { _Pragma("unroll") for (int mt = 0; mt < 4; ++mt) _Pragma("unroll") for (int kb = 0; kb < 4; ++kb) \
                X[mt][kb] = *(const bf16x8*)(XC + (size_t)((rt_) * 64 + 16 * mt + m_) * 1024 + 128 * n + 32 * kb + 8 * q_); } while (0)
            for (int rt = (int)blockIdx.x & 15; rt < NCH; rt += 16) {
                LRU_XLOAD(XAc, rt);
                if (d) lru_item<1>(args, d, n, rt, wave, lane, XAc, WAf, WXf); else lru_item<0>(args, d, n, rt, wave, lane, XAc, WAf, WXf);
            }
#undef LRU_XLOAD
        }
        if (BOTH(4)) GRID_BAR();
    }
    if (IN(5)) {
        for (int u = gw; u < 16 * NCH; u += NGW) dn_prep_unit(args, lds + wave * DN_WAVE_LDS, u, lane);
        GRID_BAR();
        const int b = blockIdx.x;
        if (b < 64) dn_scan2(args, lds, tid, (b >> 2) & 7, b >> 5, b & 3);
        else if (b < 68) lru_carry(args, (b - 64) * NTHREADS + tid);
        else {
            p0_adaln(args, lds, tid, 1, b - 68, G - 68);
            LAS float* scr = (LAS float*)(lds + wave * 16384); const int gw2 = (b - 68) * NWAVES + wave, ngw2 = (G - 68) * NWAVES;
            transpose_job<0>(args.in[IN_EVWOUT], D, D, (bf16*)(ws + WS_W_EVOUT), scr, gw2, ngw2, lane);
            transpose_job<1>(args.in[IN_EVGATE], D, FF, (bf16*)(ws + WS_W_EVGU), scr, gw2, ngw2, lane);
            transpose_job<2>(args.in[IN_EVUP], D, FF, (bf16*)(ws + WS_W_EVGU), scr, gw2, ngw2, lane);
            transpose_job<0>(args.in[IN_EVDOWN], FF, D, (bf16*)(ws + WS_W_EVDN), scr, gw2, ngw2, lane);
            transpose_job<0>(args.in[IN_ODWIN], D, EV_IN, (bf16*)(ws + WS_W_ODIN), scr, gw2, ngw2, lane);
            transpose_job<0>(args.in[IN_ODWOUT], D, D, (bf16*)(ws + WS_W_ODOUT), scr, gw2, ngw2, lane);
        }
        GRID_BAR();
        for (int u = gw; u < 16 * NCH; u += NGW) dn_out_unit(args, u, lane);
        if (BOTH(5)) GRID_BAR();
    }
    if (IN(6)) {
        for (int r = gw; r < MT; r += NGW) ev_finish_row(args, r, lane, (const bf16*)(ws + WS_ODN));
        if (BOTH(6)) GRID_BAR();
    }
    if (IN(7)) {
        if ((int)blockIdx.x < XC_GW7) {
        pg8::Gemm g{MIX, (const bf16*)(ws + WS_W_EVOUT), MT, D, D, D}; pg8::StaticOrder S; S.init(MT, D, XC_GW7, (int)blockIdx.x);
        pg8::EpiResid E{XRES, MODV(0, 0, 2), MODV(0, 1, 2), args.in[IN_X], args.in[IN_CTX]};
        pg8::gemm_phase<pg8::EpiResid, pg8::StaticOrder, true, true>(lds, g, S, E);
        } else expert_convert_range(args, (LAS float*)(lds + wave * 16384), XC_B1, XC_B2, ((int)blockIdx.x - XC_GW7) * NWAVES + wave, (G - XC_GW7) * NWAVES, lane);
        if (BOTH(7)) GRID_BAR();
    }
    if (IN(8)) {
        LAS float* nA = (LAS float*)lds; LAS float* nB = nA + D;
        norm_stage_ab(nA, nB, args.in[IN_N2G], MODV(0, 0, 3), MODV(0, 0, 4), tid); __syncthreads();
        for (int r = gw; r < MT; r += NGW) { const int cond = r >= T; f32x4 hv[8];
            if (cond) norm_row(XRES + (size_t)r * D, args.in[IN_N2G], MODV(0, 1, 3), MODV(0, 1, 4), H + (size_t)r * D, nullptr, lane, hv);
            else norm_row_ab(XRES + (size_t)r * D, nA, nB, H + (size_t)r * D, lane, hv); }
        if (BOTH(8)) GRID_BAR();
    }
    if (IN(9)) {
        if ((int)blockIdx.x < XC_GW9) {
        pg8::Gemm g{H, (const bf16*)(ws + WS_W_EVGU), MT, 2 * FF, D, D}; pg8::StaticOrder S; S.init(MT, 2 * FF, XC_GW9, (int)blockIdx.x);
        pg8::EpiSwiglu E{(bf16*)(ws + WS_HID), FF, 2 * FF / 256};
        pg8::gemm_phase<pg8::EpiSwiglu, pg8::StaticOrder, true, true>(lds, g, S, E);
        } else expert_convert_range(args, (LAS float*)(lds + wave * 16384), XC_B2, XC_B3, ((int)blockIdx.x - XC_GW9) * NWAVES + wave, (G - XC_GW9) * NWAVES, lane);
        if (BOTH(9)) GRID_BAR();
    }
    if (IN(10)) {
        if ((int)blockIdx.x < XC_GW10) {
        pg8::Gemm g{(const bf16*)(ws + WS_HID), (const bf16*)(ws + WS_W_EVDN), MT, D, FF, FF}; pg8::StaticOrder S; S.init(MT, D, XC_GW10, (int)blockIdx.x);
        pg8::EpiResid E{XRES, MODV(0, 0, 5), MODV(0, 1, 5), nullptr, nullptr};
        pg8::gemm_phase<pg8::EpiResid, pg8::StaticOrder, true, true>(lds, g, S, E);
        } else expert_convert_range(args, (LAS float*)(lds + wave * 16384), XC_B3, XC_B4, ((int)blockIdx.x - XC_GW10) * NWAVES + wave, (G - XC_GW10) * NWAVES, lane);
        if (BOTH(10)) GRID_BAR();
    }
    if (IN(11)) {
        LAS float* nA = (LAS float*)lds; LAS float* nB = nA + D;
        norm_stage_ab(nA, nB, args.in[IN_N1G] + D, MODV(1, 0, 0), MODV(1, 0, 1), tid); __syncthreads();
        for (int r = gw; r < MT; r += NGW) { const int cond = r >= T; f32x4 hv[8];
            const int dstr = cond ? r : ((r & 63) * 256 + (r >> 6));
            if (cond) norm_row(XRES + (size_t)r * D, args.in[IN_N1G] + D, MODV(1, 1, 0), MODV(1, 1, 1), H + (size_t)dstr * D, nullptr, lane, hv);
            else norm_row_ab(XRES + (size_t)r * D, nA, nB, H + (size_t)dstr * D, lane, hv); }
        if (BOTH(11)) GRID_BAR();
    }
    if (IN(12)) {
        if ((int)blockIdx.x < XC_GW12) {
        pg8::Gemm g{H, (const bf16*)(ws + WS_W_ODIN), MT, NPROJ_PAD, D, D}; pg8::StaticOrder S; S.init(MT, NPROJ_PAD, XC_GW12, (int)blockIdx.x);
        pg8::EpiProj E{(bf16*)(ws + WS_PROJ), (float*)(ws + WS_AUX), NPROJ, NPROJ / 256};
        pg8::gemm_phase<pg8::EpiProj, pg8::StaticOrder, true, true>(lds, g, S, E);
        } else expert_convert_range(args, (LAS float*)(lds + wave * 16384), XC_B4, XC_B5, ((int)blockIdx.x - XC_GW12) * NWAVES + wave, (G - XC_GW12) * NWAVES, lane);
        if (BOTH(12)) GRID_BAR();
    }
    if (IN(13)) {
        const int b = blockIdx.x;
        for (int u = b; u < 8 * NCH; u += G) gla_prep_unit(args, lds, tid, u);
        GRID_BAR();
        { const int g = b & 7, qv = (b >> 3) & 3, hh = (b >> 5) & 3, dd = b >> 7;
          if (b < 256 && g < GSEG - 1) gla_scan<0>(args, lds, tid, hh, dd, qv, g);
          GRID_BAR();
          if (b < 256) gla_scan<1>(args, lds, tid, hh, dd, qv, g); }
        if (BOTH(13)) GRID_BAR();
    }
    if (IN(14)) {
        for (int n = gw; n < T; n += NGW) od_finish_row(args, n, lane);
        if (BOTH(14)) GRID_BAR();
    }
    if (IN(15)) {
        pg8::Gemm g{MIX, (const bf16*)(ws + WS_W_ODOUT), T, D, D, D}; pg8::StaticOrder S; S.init(T, D, G, (int)blockIdx.x);
        pg8::EpiResid E{XRES, MODV(1, 0, 2), MODV(1, 1, 2), nullptr, nullptr};
        pg8::gemm_phase<pg8::EpiResid, pg8::StaticOrder, true, true>(lds, g, S, E);
        if (BOTH(15)) GRID_BAR();
    }
    int* TOPI = (int*)(ws + WS_SMALL + SM_TOPI); float* TOPW = (float*)(ws + WS_SMALL + SM_TOPW); int* POS = (int*)(ws + WS_SMALL + SM_POS);
    int* SLOT = (int*)(ws + WS_SMALL + SM_SLOT); int* WGBASE = (int*)(ws + WS_SMALL + SM_WGBASE);
    if (IN(16)) {
        LAS int* hist = (LAS int*)lds;
        LAS float* rws = (LAS float*)(lds + 1024);
        for (int i = tid; i < D * 8 / 4; i += NTHREADS) ((LAS f32x4*)rws)[i] = ((const f32x4*)args.in[IN_RW])[i];
        LAS float* nA = (LAS float*)(lds + 1024 + 65536); LAS float* nB = nA + D;
        norm_stage_ab(nA, nB, args.in[IN_N2G] + D, MODV(1, 0, 3), MODV(1, 0, 4), tid);
        if (tid < 8) hist[tid] = 0;
        { int* ROWMAP = (int*)(ws + WS_SMALL + SM_ROWMAP); for (int i = blockIdx.x * NTHREADS + tid; i < XS_ROWS; i += G * NTHREADS) ROWMAP[i] = 0; }
        __syncthreads();
        int wcnt[8];
#pragma unroll
        for (int e = 0; e < 8; ++e) wcnt[e] = 0;
        for (int n = gw; n < T; n += NGW) { f32x4 hv[8];
            asm volatile("" ::: "memory");
            norm_row_ab(XRES + (size_t)n * D, nA, nB, H + (size_t)n * D, lane, hv);
            float lg[8];
#pragma unroll
            for (int e = 0; e < 8; ++e) lg[e] = 0.f;
#pragma unroll
            for (int j = 0; j < 8; ++j)
#pragma unroll
                for (int q = 0; q < 4; ++q) { const int c = 4 * lane + 256 * j + q; const f32x4 w0 = *(const LAS f32x4*)(rws + c * 8), w1 = *(const LAS f32x4*)(rws + c * 8 + 4);
                    const float x = hv[j][q];
#pragma unroll
                    for (int e = 0; e < 4; ++e) { lg[e] += x * w0[e]; lg[4 + e] += x * w1[e]; } }
#pragma unroll
            for (int e = 0; e < 8; ++e) lg[e] = wave_sum(lg[e]) + args.in[IN_RB][e];
            if (lane == 0) {
                int i0 = 0; float l0 = lg[0];
#pragma unroll
                for (int e = 1; e < 8; ++e) if (lg[e] > l0) { l0 = lg[e]; i0 = e; }
                int i1 = -1; float l1 = -3.0e38f;
#pragma unroll
                for (int e = 0; e < 8; ++e) if (e != i0 && lg[e] > l1) { l1 = lg[e]; i1 = e; }
                if (i1 < 0) i1 = (i0 + 1) & 7;
                const float w0 = 1.0f / (1.0f + fexp(l1 - l0));
                TOPI[2 * n] = i0; TOPI[2 * n + 1] = i1; TOPW[2 * n] = w0; TOPW[2 * n + 1] = 1.0f - w0;
                int p0 = 0, p1 = 0;
#pragma unroll
                for (int e = 0; e < 8; ++e) { if (e == i0) { p0 = wcnt[e]; wcnt[e] += 1; } }
#pragma unroll
                for (int e = 0; e < 8; ++e) { if (e == i1) { p1 = wcnt[e]; wcnt[e] += 1; } }
                POS[2 * n] = p0; POS[2 * n + 1] = p1;
            }
        }
        if (lane == 0) {
#pragma unroll
            for (int e = 0; e < 8; ++e) hist[8 + wave * 8 + e] = wcnt[e]; }
        __syncthreads();
        if (tid < 8) { int run = 0; int* WVPRE = (int*)(ws + WS_SMALL + SM_WVPRE);
            for (int w2 = 0; w2 < 8; ++w2) { WVPRE[(blockIdx.x * 8 + w2) * 8 + tid] = run; run += hist[8 + w2 * 8 + tid]; }
            ((int*)(ws + WS_SMALL + SM_WGCNT))[blockIdx.x * 8 + tid] = run; atomicAdd(ctl + CW_CNT + tid, (unsigned)run); }
        if (BOTH(16)) GRID_BAR();
    }
    int tend[8]; int Mt = 0; int pstart[8];
    if (hi > 17) {
#pragma unroll
        for (int e = 0; e < 8; ++e) { const int c = (int)__hip_atomic_load(ctl + CW_CNT + e, __ATOMIC_RELAXED, __HIP_MEMORY_SCOPE_AGENT); pstart[e] = Mt * 256; Mt += (c + 255) >> 8; tend[e] = Mt; }
    }
    if (IN(17)) {
        int* ROWMAP = (int*)(ws + WS_SMALL + SM_ROWMAP); const int* WVPRE = (const int*)(ws + WS_SMALL + SM_WVPRE); const int* WGCNT = (const int*)(ws + WS_SMALL + SM_WGCNT);
        LAS int* wgpre = (LAS int*)lds;
        if (tid < 8) { int run = 0; for (int w2 = 0; w2 < G; ++w2) { wgpre[w2 * 8 + tid] = run; run += WGCNT[w2 * 8 + tid]; } }
        __syncthreads();
        for (int n = blockIdx.x * NTHREADS + tid; n < T; n += G * NTHREADS) {
            const int gwn = n % NGW;
#pragma unroll
            for (int k = 0; k < 2; ++k) { const int e = TOPI[2 * n + k]; int ps = 0;
#pragma unroll
                for (int q = 0; q < 8; ++q) ps = (q == e) ? pstart[q] : ps;
                const int slot = ps + wgpre[(gwn / NWAVES) * 8 + e] + WVPRE[gwn * 8 + e] + POS[2 * n + k];
                SLOT[2 * n + k] = slot; ROWMAP[slot] = n; }
        }
        if (BOTH(17)) GRID_BAR();
    }
    if (IN(18)) {
        pg8::Gemm g{H, (const bf16*)(ws + WS_W_XGU), Mt * 256, 2 * FF, D, D};
        pg8::MoeOrder S; S.nN = 2 * FF / 256; S.Mt = Mt; S.nwg = Mt * S.nN; S.G = G; S.c = (int)blockIdx.x;
#pragma unroll
        for (int e = 0; e < 8; ++e) S.tend[e] = tend[e];
        pg8::EpiSwiglu E{(bf16*)(ws + WS_HID2), FF, 2 * FF / 256};
        pg8::gemm_phase_gather<pg8::EpiSwiglu, pg8::MoeOrder>(lds, g, (const int*)(ws + WS_SMALL + SM_ROWMAP), S, E);
        if (BOTH(18)) GRID_BAR();
    }
    if (IN(19)) {
        const int Mmain = Mt < 128 ? Mt : 128;
        { pg8::Gemm g{(const bf16*)(ws + WS_HID2), (const bf16*)(ws + WS_W_XDN), Mmain * 256, D, FF, FF};
          pg8::MoeOrder S; S.nN = D / 256; S.Mt = Mmain; S.nwg = Mmain * S.nN; S.G = G; S.c = (int)blockIdx.x;
#pragma unroll
          for (int e = 0; e < 8; ++e) S.tend[e] = tend[e];
          pg8::EpiBf16N E{(bf16*)(ws + WS_YB), D, D / 256};
          pg8::gemm_phase<pg8::EpiBf16N, pg8::MoeOrder, true, true>(lds, g, S, E); }
        if (Mt > 128) {
          pg8::Gemm g{(const bf16*)(ws + WS_HID2), (const bf16*)(ws + WS_W_XDN), Mt * 256, D, FF / 4, FF};
          pg8::MoeSplitOrder S; S.nN = D / 256; S.tile0 = 128; S.Mt = Mt; S.KS = 4; S.Ksub = FF / 4; S.nwg = (Mt - 128) * S.nN * 4; S.G = G; S.c = (int)blockIdx.x;
#pragma unroll
          for (int e = 0; e < 8; ++e) S.tend[e] = tend[e];
          pg8::EpiF32Part E{(float*)(ws + WS_YBX), 128 * 256, 8 * 256, D, D / 256, FF / 4};
          pg8::gemm_phase<pg8::EpiF32Part, pg8::MoeSplitOrder, true, true>(lds, g, S, E); }
        if (BOTH(19)) GRID_BAR();
    }
    if (IN(20)) {
        const bf16* YB = (const bf16*)(ws + WS_YB); const float* YBX = (const float*)(ws + WS_YBX);
        LAS float* gt2 = (LAS float*)lds; LAS float* fng = gt2 + D;
        for (int i = tid; i < D; i += NTHREADS) { gt2[i] = MODV(1, 0, 5)[i]; fng[i] = args.in[IN_FNG][i]; }
        __syncthreads();
        for (int n = gw; n < T; n += NGW) {
            const int s0 = SLOT[2 * n], s1 = SLOT[2 * n + 1]; const float w0 = TOPW[2 * n], w1 = TOPW[2 * n + 1];
            f32x4 v[8]; float ss = 0.f;
#pragma unroll
            for (int j = 0; j < 8; ++j) { const int c = 4 * lane + 256 * j;
                f32x4 ya, yb;
                if (s0 < 32768) { const u32x2 a0 = *(const u32x2*)(YB + (size_t)s0 * D + c); ya = (f32x4){bf2f(a0.x & 0xffffu), bf2f(a0.x >> 16), bf2f(a0.y & 0xffffu), bf2f(a0.y >> 16)}; }
                else { const float* pp = YBX + (size_t)(s0 - 32768) * D + c; ya = (*(const f32x4*)pp + *(const f32x4*)(pp + (size_t)2048 * D)) + (*(const f32x4*)(pp + (size_t)4096 * D) + *(const f32x4*)(pp + (size_t)6144 * D)); }
                if (s1 < 32768) { const u32x2 a1 = *(const u32x2*)(YB + (size_t)s1 * D + c); yb = (f32x4){bf2f(a1.x & 0xffffu), bf2f(a1.x >> 16), bf2f(a1.y & 0xffffu), bf2f(a1.y >> 16)}; }
                else { const float* pp = YBX + (size_t)(s1 - 32768) * D + c; yb = (*(const f32x4*)pp + *(const f32x4*)(pp + (size_t)2048 * D)) + (*(const f32x4*)(pp + (size_t)4096 * D) + *(const f32x4*)(pp + (size_t)6144 * D)); }
                const f32x4 y = ya * w0 + yb * w1;
                v[j] = *(const f32x4*)(XRES + (size_t)n * D + c) + *(const LAS f32x4*)(gt2 + c) * y;
                ss += (v[j][0] * v[j][0] + v[j][1] * v[j][1]) + (v[j][2] * v[j][2] + v[j][3] * v[j][3]); }
            const float rstd = 1.0f / sqrtf(wave_sum(ss) * (1.0f / D) + EPS);
#pragma unroll
            for (int j = 0; j < 8; ++j) { const int c = 4 * lane + 256 * j; f32x4 ov = v[j] * rstd * *(const LAS f32x4*)(fng + c);
                *(f32x4*)(args.out + (size_t)n * D + c) = ov; }
        }
    }
#undef IN
#undef BOTH
}

extern "C" void kernel_launch(void* const* d_in, const int* in_sizes, int n_in, void* d_out, int out_size, void* d_ws, size_t ws_size, hipStream_t stream) {
    static int grid = 0;
    if (grid == 0) {
        if (n_in != N_IN || out_size != T * D || ws_size < (WS_END > WS_L0_END ? WS_END : WS_L0_END)) { fprintf(stderr, "kernel_launch: unexpected shapes (n_in %d, out %d, ws %zu)\n", n_in, out_size, ws_size); grid = -1; return; }
        int dev = 0, cus = 0, per_cu = 0;
        if (hipGetDevice(&dev) != hipSuccess || hipDeviceGetAttribute(&cus, hipDeviceAttributeMultiprocessorCount, dev) != hipSuccess) { grid = -1; return; }
        if (hipFuncSetAttribute((const void*)fwd_kernel, hipFuncAttributeMaxDynamicSharedMemorySize, LDS_BYTES) != hipSuccess) { fprintf(stderr, "kernel_launch: hipFuncSetAttribute failed\n"); grid = -1; return; }
        if (hipOccupancyMaxActiveBlocksPerMultiprocessor(&per_cu, (const void*)fwd_kernel, NTHREADS, LDS_BYTES) != hipSuccess || per_cu < 1) fprintf(stderr, "kernel_launch: occupancy query says %d\n", per_cu);
        (void)hipGetLastError();
        grid = cus;
    }
    if (grid < 0) return;
    (void)hipMemsetAsync((char*)d_ws + WS_CTL, 0, CTL_BYTES, stream);
    Args a{};
    for (int i = 0; i < N_IN; ++i) a.in[i] = (const float*)d_in[i];
    a.out = (float*)d_out; a.ws = (unsigned char*)d_ws;
    a.ph_lo = 0; a.ph_hi = N_PHASES;
    hipLaunchKernelGGL(fwd_kernel, dim3(grid), dim3(NTHREADS), LDS_BYTES, stream, a);
}
```
